# Optimizing an MI355X kernel written in HIP

```python
import math
import jax
import jax.numpy as jnp
from jax import lax
import numpy as np


D_MODEL = 1024
BATCH = 4
SEQ = 4096
DEPTH = 4

N_A_LAYERS = DEPTH // 2
N_B_LAYERS = DEPTH - N_A_LAYERS
N_HEADS = 8
A_HEAD_DIM = 64
A_QK_WIDTH = N_HEADS * 2 * A_HEAD_DIM
A_V_WIDTH = N_HEADS * 2 * A_HEAD_DIM
B_GROUPS = ((128, 1), (512, 4), (2048, 16))
B_NUM_GROUPS = len(B_GROUPS)
B_HEAD_DIM = 64
B_QK_WIDTH = B_NUM_GROUPS * N_HEADS * B_HEAD_DIM
B_OUT_WIDTH = N_HEADS * B_HEAD_DIM
Q_BLOCK = 128
REL_BUCKETS = 32
REL_MAX_EXACT = 16
REL_MAX_DIST = 2048
MOE_GROUPS = 4
MOE_EXPERTS_PER_GROUP = 8
MOE_EXPERTS = MOE_GROUPS * MOE_EXPERTS_PER_GROUP
MOE_TOP_K = 2
MOE_HIDDEN = 512
MOE_BLOCK = 128
EPS = 1e-6

kernel_name = 'hybrid_yoco_diffattn_dilated_hmoe'


def rmsnorm(t, g):
    t32 = t.astype(jnp.float32)
    y = t32 * lax.rsqrt(jnp.mean(t32 * t32, axis=-1, keepdims=True) + EPS)
    return (y * g.astype(jnp.float32)).astype(t.dtype)


def modulate(h, shift, scale):
    return h * (1 + scale[:, None, :]) + shift[:, None, :]


def t5_bucket(dist):
    n = jnp.maximum(dist, 0)
    nf = jnp.maximum(n, 1).astype(jnp.float32)
    large = REL_MAX_EXACT + (jnp.log(nf / REL_MAX_EXACT) / math.log(REL_MAX_DIST / REL_MAX_EXACT)
                             * (REL_BUCKETS - REL_MAX_EXACT)).astype(jnp.int32)
    large = jnp.minimum(large, REL_BUCKETS - 1)
    return jnp.where(n < REL_MAX_EXACT, n, large)


def lambda_init(layer):
    return 0.8 - 0.6 * math.exp(-0.3 * layer)


def diff_attention(h, w_qkv, q_gain, k_gain, lam_p, subln_gain, w_o, rel_bias, lam_init):
    b, s, _ = h.shape
    q, k, v = jnp.split(h @ w_qkv, [A_QK_WIDTH, 2 * A_QK_WIDTH], axis=-1)
    q = rmsnorm(q.reshape(b, s, N_HEADS, 2, A_HEAD_DIM), q_gain)
    k = rmsnorm(k.reshape(b, s, N_HEADS, 2, A_HEAD_DIM), k_gain)
    v = v.reshape(b, s, N_HEADS, 2 * A_HEAD_DIM)
    lp = lam_p.astype(jnp.float32)
    lam = jnp.exp(jnp.sum(lp[0] * lp[1])) - jnp.exp(jnp.sum(lp[2] * lp[3])) + lam_init
    scale = A_HEAD_DIM ** -0.5
    k_pos = jnp.arange(s)

    def block(i):
        start = i * Q_BLOCK
        q_blk = lax.dynamic_slice_in_dim(q, start, Q_BLOCK, axis=1)
        logits = jnp.einsum('bqhcd,bkhcd->bchqk', q_blk, k,
                            preferred_element_type=jnp.float32) * scale
        dist = (start + jnp.arange(Q_BLOCK))[:, None] - k_pos[None, :]
        bias = jnp.transpose(rel_bias[t5_bucket(dist)], (2, 0, 1)).astype(jnp.float32)
        logits = jnp.where(dist >= 0, logits + bias, -jnp.inf)
        p = jax.nn.softmax(logits, axis=-1)
        attn = p[:, 0] - lam * p[:, 1]
        return jnp.einsum('bhqk,bkhe->bqhe', attn.astype(v.dtype), v)

    o = lax.map(block, jnp.arange(s // Q_BLOCK))
    o = jnp.moveaxis(o, 0, 1).reshape(b, s, N_HEADS, 2 * A_HEAD_DIM)
    o = rmsnorm(o, subln_gain) * (1 - lam_init)
    return o.reshape(b, s, A_V_WIDTH) @ w_o


def _to_subseq(t, dil):
    b, s = t.shape[:2]
    rest = t.shape[2:]
    length = s // dil
    t = jnp.swapaxes(t.reshape((b, length, dil) + rest), 1, 2).reshape((b * dil, length) + rest)
    lp = -(-length // Q_BLOCK) * Q_BLOCK
    return jnp.pad(t, [(0, 0), (0, lp - length)] + [(0, 0)] * len(rest))


def _from_subseq(t, b, s, dil):
    length = s // dil
    rest = t.shape[2:]
    t = t[:, :length].reshape((b, dil, length) + rest)
    return jnp.swapaxes(t, 1, 2).reshape((b, s) + rest)


def _key_blocks(t):
    bp, lp = t.shape[:2]
    rest = t.shape[2:]
    nb = lp // Q_BLOCK
    tp = jnp.pad(t, [(0, 0), (Q_BLOCK, 0)] + [(0, 0)] * len(rest))
    prev = tp[:, :lp].reshape((bp, nb, Q_BLOCK) + rest)
    cur = tp[:, Q_BLOCK:].reshape((bp, nb, Q_BLOCK) + rest)
    return jnp.concatenate([prev, cur], axis=2)


def _band_bias_mask(band, dil, nb, rel_bias):
    i = jnp.arange(Q_BLOCK)[:, None]
    j = jnp.arange(2 * Q_BLOCK)[None, :]
    rel = i + Q_BLOCK - j
    key_idx = jnp.arange(nb)[:, None, None] * Q_BLOCK + j[None] - Q_BLOCK
    mask = (rel >= 0)[None] & (rel <= band)[None] & (key_idx >= 0)
    bias = jnp.transpose(rel_bias[t5_bucket(dil * rel)], (2, 0, 1)).astype(jnp.float32)
    return bias, mask


def shared_dilated_kv(x, c_act, kv_norm, kv_ada_w, kv_ada_b, kv_w, kv_k_norm):
    b, s, _ = x.shape
    shift, scale = jnp.split(c_act @ kv_ada_w + kv_ada_b, 2, axis=-1)
    h = modulate(rmsnorm(x, kv_norm), shift, scale)
    k, v = jnp.split(h @ kv_w, 2, axis=-1)
    k = rmsnorm(k.reshape(b, s, B_NUM_GROUPS, N_HEADS, B_HEAD_DIM), kv_k_norm[:, None, :])
    v = v.reshape(b, s, B_NUM_GROUPS, N_HEADS, B_HEAD_DIM)
    blocks = []
    for g, (_, dil) in enumerate(B_GROUPS):
        blocks.append((_key_blocks(_to_subseq(k[:, :, g], dil)),
                       _key_blocks(_to_subseq(v[:, :, g], dil))))
    return blocks


def dilated_attention(h, w_q, q_gain, w_o, kv_blocks, rel_bias):
    b, s, _ = h.shape
    q = rmsnorm((h @ w_q).reshape(b, s, B_NUM_GROUPS, N_HEADS, B_HEAD_DIM), q_gain[:, None, :])
    scale = B_HEAD_DIM ** -0.5
    outs, lses = [], []
    for g, (window, dil) in enumerate(B_GROUPS):
        kb, vb = kv_blocks[g]
        bp, nb = kb.shape[:2]
        qb = _to_subseq(q[:, :, g], dil).reshape(bp, nb, Q_BLOCK, N_HEADS, B_HEAD_DIM)
        bias, mask = _band_bias_mask(window // dil, dil, nb, rel_bias)
        logits = jnp.einsum('bnqhd,bnkhd->bnhqk', qb, kb,
                            preferred_element_type=jnp.float32) * scale
        logits = jnp.where(mask[None, :, None], logits + bias[None, None], -jnp.inf)
        lse = jax.nn.logsumexp(logits, axis=-1)
        p = jnp.exp(logits - lse[..., None])
        o = jnp.einsum('bnhqk,bnkhd->bnqhd', p.astype(vb.dtype), vb)
        outs.append(_from_subseq(o.reshape(bp, nb * Q_BLOCK, N_HEADS, B_HEAD_DIM), b, s, dil))
        lses.append(_from_subseq(jnp.swapaxes(lse, 2, 3).reshape(bp, nb * Q_BLOCK, N_HEADS), b, s, dil))
    w = jax.nn.softmax(jnp.stack(lses, axis=2), axis=2)
    o = jnp.einsum('bsgh,bsghd->bshd', w.astype(outs[0].dtype), jnp.stack(outs, axis=2))
    return o.reshape(b, s, B_OUT_WIDTH) @ w_o


def hier_moe(h, w_group, b_group, w_expert, b_expert, w_gate, w_up, w_down):
    t = h.shape[0]
    g_logits = (h @ w_group).astype(jnp.float32) + b_group.astype(jnp.float32)
    g_idx = jnp.argmax(g_logits, axis=-1)
    g_w = jnp.take_along_axis(jax.nn.softmax(g_logits, axis=-1), g_idx[:, None], axis=1)
    e_logits = ((h @ w_expert).astype(jnp.float32) + b_expert.astype(jnp.float32)).reshape(
        t, MOE_GROUPS, MOE_EXPERTS_PER_GROUP)
    e_sel = jnp.take_along_axis(e_logits, g_idx[:, None, None], axis=1)[:, 0]
    top_v, top_i = lax.top_k(e_sel, MOE_TOP_K)
    gates = g_w * jax.nn.softmax(top_v, axis=-1)
    eid = (g_idx[:, None] * MOE_EXPERTS_PER_GROUP + top_i).reshape(-1)
    tok = jnp.repeat(jnp.arange(t), MOE_TOP_K)
    wts = gates.reshape(-1)
    n_assign = t * MOE_TOP_K
    order = jnp.argsort(eid)
    eid_s, tok_s, wts_s = eid[order], tok[order], wts[order]
    counts = jax.ops.segment_sum(jnp.ones_like(eid_s), eid_s, num_segments=MOE_EXPERTS)
    starts = jnp.cumsum(counts) - counts
    padded = (counts + MOE_BLOCK - 1) // MOE_BLOCK * MOE_BLOCK
    pad_end = jnp.cumsum(padded)
    pad_start = pad_end - padded
    dest = pad_start[eid_s] + jnp.arange(n_assign) - starts[eid_s]
    n_blocks = -(-n_assign // MOE_BLOCK) + MOE_EXPERTS
    rows = n_blocks * MOE_BLOCK
    row_tok = jnp.zeros((rows,), jnp.int32).at[dest].set(tok_s)
    row_w = jnp.zeros((rows,), jnp.float32).at[dest].set(wts_s)
    block_e = jnp.minimum(jnp.searchsorted(pad_end, jnp.arange(n_blocks) * MOE_BLOCK, side='right'),
                          MOE_EXPERTS - 1)
    xs = h[row_tok].reshape(n_blocks, MOE_BLOCK, h.shape[1])

    def expert_block(args):
        xb, e = args
        return (jax.nn.silu(xb @ w_gate[e]) * (xb @ w_up[e])) @ w_down[e]

    ys = lax.map(expert_block, (xs, block_e)).reshape(rows, h.shape[1])
    return jnp.zeros_like(h).at[row_tok].add(ys * row_w[:, None].astype(h.dtype))


def setup_inputs(seed: int = 0) -> dict:
    key = jax.random.key(seed)
    ks = jax.random.split(key, 28)
    D = D_MODEL

    def nrm(k, shape, scale):
        return jax.random.normal(k, shape, jnp.float32) * scale

    def gain(k, shape):
        return 1.0 + 0.02 * jax.random.normal(k, shape, jnp.float32)

    return {
        'x': nrm(ks[0], (BATCH, SEQ, D), 1.0),
        'c': nrm(ks[1], (BATCH, D), 1.0),
        'rel_bias': nrm(ks[2], (REL_BUCKETS, N_HEADS), 0.5),
        'ada_w': nrm(ks[3], (DEPTH, D, 6 * D), 0.02),
        'ada_b': nrm(ks[4], (DEPTH, 6 * D), 0.02),
        'norm_attn': gain(ks[5], (DEPTH, D)),
        'norm_ffn': gain(ks[6], (DEPTH, D)),
        'a_w_qkv': nrm(ks[7], (N_A_LAYERS, D, 2 * A_QK_WIDTH + A_V_WIDTH), D ** -0.5),
        'a_q_norm': gain(ks[8], (N_A_LAYERS, A_HEAD_DIM)),
        'a_k_norm': gain(ks[9], (N_A_LAYERS, A_HEAD_DIM)),
        'a_lambda': nrm(ks[10], (N_A_LAYERS, 4, A_HEAD_DIM), 0.1),
        'a_subln': gain(ks[11], (N_A_LAYERS, 2 * A_HEAD_DIM)),
        'a_w_o': nrm(ks[12], (N_A_LAYERS, A_V_WIDTH, D), A_V_WIDTH ** -0.5),
        'kv_norm': gain(ks[13], (D,)),
        'kv_ada_w': nrm(ks[14], (D, 2 * D), 0.02),
        'kv_ada_b': nrm(ks[15], (2 * D,), 0.02),
        'kv_w': nrm(ks[16], (D, 2 * B_QK_WIDTH), D ** -0.5),
        'kv_k_norm': gain(ks[17], (B_NUM_GROUPS, B_HEAD_DIM)),
        'b_w_q': nrm(ks[18], (N_B_LAYERS, D, B_QK_WIDTH), D ** -0.5),
        'b_q_norm': gain(ks[19], (N_B_LAYERS, B_NUM_GROUPS, B_HEAD_DIM)),
        'b_w_o': nrm(ks[20], (N_B_LAYERS, B_OUT_WIDTH, D), B_OUT_WIDTH ** -0.5),
        'moe_w_group': nrm(ks[21], (DEPTH, D, MOE_GROUPS), D ** -0.5),
        'moe_b_group': nrm(ks[22], (DEPTH, MOE_GROUPS), 0.01),
        'moe_w_expert': nrm(ks[23], (DEPTH, D, MOE_EXPERTS), D ** -0.5),
        'moe_b_expert': nrm(ks[24], (DEPTH, MOE_EXPERTS), 0.01),
        'moe_w_gate': nrm(ks[25], (DEPTH, MOE_EXPERTS, D, MOE_HIDDEN), D ** -0.5),
        'moe_w_up': nrm(ks[26], (DEPTH, MOE_EXPERTS, D, MOE_HIDDEN), D ** -0.5),
        'moe_w_down': nrm(ks[27], (DEPTH, MOE_EXPERTS, MOE_HIDDEN, D), MOE_HIDDEN ** -0.5),
    }


def reference(x, c, rel_bias, ada_w, ada_b, norm_attn, norm_ffn, a_w_qkv, a_q_norm, a_k_norm,
              a_lambda, a_subln, a_w_o, kv_norm, kv_ada_w, kv_ada_b, kv_w, kv_k_norm,
              b_w_q, b_q_norm, b_w_o, moe_w_group, moe_b_group, moe_w_expert, moe_b_expert,
              moe_w_gate, moe_w_up, moe_w_down):
    b, s, d = x.shape
    c_act = jax.nn.silu(c)
    kv_blocks = None
    for layer in range(DEPTH):
        mod = c_act @ ada_w[layer] + ada_b[layer]
        sh_a, sc_a, g_a, sh_f, sc_f, g_f = jnp.split(mod, 6, axis=-1)
        h = modulate(rmsnorm(x, norm_attn[layer]), sh_a, sc_a)
        if layer < N_A_LAYERS:
            y = diff_attention(h, a_w_qkv[layer], a_q_norm[layer], a_k_norm[layer], a_lambda[layer],
                               a_subln[layer], a_w_o[layer], rel_bias, lambda_init(layer))
        else:
            if layer == N_A_LAYERS:
                kv_blocks = shared_dilated_kv(x, c_act, kv_norm, kv_ada_w, kv_ada_b, kv_w, kv_k_norm)
            j = layer - N_A_LAYERS
            y = dilated_attention(h, b_w_q[j], b_q_norm[j], b_w_o[j], kv_blocks, rel_bias)
        x = x + g_a[:, None, :] * y
        h = modulate(rmsnorm(x, norm_ffn[layer]), sh_f, sc_f)
        y = hier_moe(h.reshape(b * s, d), moe_w_group[layer], moe_b_group[layer], moe_w_expert[layer],
                     moe_b_expert[layer], moe_w_gate[layer], moe_w_up[layer], moe_w_down[layer])
        x = x + g_f[:, None, :] * y.reshape(b, s, d)
    return x
```

```cpp
#include <hip/hip_runtime.h>
#include <cstdio>
#include <cstdint>

#ifndef MK_N_LAUNCHES
#define MK_N_LAUNCHES 1
#endif

#define GAS __attribute__((address_space(1)))
#define LAS __attribute__((address_space(3)))
typedef unsigned short bf16;
typedef unsigned v4u __attribute__((ext_vector_type(4)));
typedef unsigned v2u __attribute__((ext_vector_type(2)));
typedef float f32x4 __attribute__((ext_vector_type(4)));
typedef float f32x2 __attribute__((ext_vector_type(2)));
typedef float f32x16 __attribute__((ext_vector_type(16)));
typedef short bf16x8 __attribute__((ext_vector_type(8)));
typedef short s16x4 __attribute__((ext_vector_type(4)));
typedef GAS unsigned gu32;
#define RLX_AGENT __ATOMIC_RELAXED, __HIP_MEMORY_SCOPE_AGENT
#define LDS_WAIT() asm volatile("s_waitcnt lgkmcnt(0)" ::: "memory")
#define VM_WAIT() asm volatile("s_waitcnt vmcnt(0)" ::: "memory")

__device__ __forceinline__ unsigned cvt_pk_bf16(float lo, float hi) { unsigned r; asm volatile("v_cvt_pk_bf16_f32 %0, %1, %2" : "=v"(r) : "v"(lo), "v"(hi)); return r; }
typedef __bf16 bf16x2_t __attribute__((ext_vector_type(2)));
__device__ __forceinline__ unsigned cvtpk_s(float lo, float hi) { f32x2 v = {lo, hi}; bf16x2_t b = __builtin_convertvector(v, bf16x2_t); return __builtin_bit_cast(unsigned, b); }
__device__ __forceinline__ float bf_lo(unsigned u) { return __builtin_bit_cast(float, u << 16); }
__device__ __forceinline__ float bf_hi(unsigned u) { return __builtin_bit_cast(float, u & 0xffff0000u); }

constexpr int D = 1024, BATCH = 4, SEQ = 4096, T = BATCH * SEQ;
constexpr int NE = 32;
constexpr int ROWCAP = T;
constexpr float EPS = 1e-6f;
constexpr float LOG2E = 1.4426950408889634f;
constexpr float QSCALE = 0.125f * LOG2E;

namespace pg8 {
#define PG8_LAS __attribute__((address_space(3)))
typedef unsigned short bf16_t;
constexpr int BM = 256, BK = 64, HALF = 128, HTB = HALF * BK * 2  , STAGE_BYTES = 8 * HTB, NXCD = 8, WGM = 4;

__host__ __device__ __forceinline__ int lds_byte(int r, int c) { const int st = (r >> 4) * 2 + (c >> 5), rr = r & 15, cc = c & 31, ob = rr * 64 + cc * 2; return st * 1024 + (ob ^ (((ob >> 9) & 1) << 5)); }
__host__ __device__ __forceinline__ void stage_rc(int b, int& R, int& C) { const int st = b / 1024, sb = b % 1024, swz = sb ^ (((sb >> 9) & 1) << 5); R = (st >> 1) * 16 + swz / 64; C = (st & 1) * 32 + (swz % 64) / 2; }
__host__ __device__ __forceinline__ int perm32(int rho) { const int n = rho >> 4, i = rho & 15; return 8 * (i >> 2) + 4 * n + (i & 3); }

struct Unit { int pm, pn, e, rt, h; };
struct Gemm { const bf16_t* A; const bf16_t* Bt; int M, N, K; };

struct StaticOrder {
    static constexpr bool GATHER = false, MOE = false, A_SC1 = false;
    int nM, nN, nwg, G, c;
    __host__ __device__ __forceinline__ void init(int M, int N, int G_, int c_) { nM = M / BM; nN = N / BM; nwg = nM * nN; G = G_; c = c_; }
    __host__ __device__ __forceinline__ bool next(int i, Unit& u) const {
        const long L = (long)i * G + c; if (L >= nwg) return false;
        int wgid = (int)L; { const int q = nwg / NXCD, r = nwg % NXCD, xcd = wgid % NXCD, off = wgid / NXCD; wgid = (xcd < r ? xcd * (q + 1) : r * (q + 1) + (xcd - r) * q) + off; }
        const int nig = WGM * nN, gid = wgid / nig, fm = gid * WGM, gsz = (nM - fm) < WGM ? (nM - fm) : WGM;
        u.pm = fm + ((wgid % nig) % gsz); u.pn = (wgid % nig) / gsz; u.e = 0; u.rt = 0; u.h = 0; return true;
    }
    __device__ __forceinline__ unsigned goff(int, int) const { return 0u; }
    __device__ __forceinline__ void wait_ready(const Unit&) const {}
};

template <class Epi, class Sched>
__device__ __forceinline__ void gemm_phase(PG8_LAS unsigned char* lds, const Gemm g, const Sched& S, const Epi& E) {
    constexpr bool GATHER = Sched::GATHER; constexpr bool GATHER_OR_MOE = Sched::MOE;
    int tid_ = threadIdx.x; asm volatile("" : "+v"(tid_));
    const int tid = tid_, wid = __builtin_amdgcn_readfirstlane(tid >> 6), lane = tid & 63, wr = wid >> 2, wc = wid & 3, fr = lane & 15, fq = lane >> 4;
    const int K = g.K, nt = K / BK;
    unsigned voffA[2], voffB[2]; int RA[2], CA[2];
#pragma unroll
    for (int i = 0; i < 2; ++i) { int R, C; stage_rc(tid * 16 + i * 8192, R, C); const int Rb = Epi::PERM ? ((R & ~31) + perm32(R & 31)) : R;
        voffA[i] = (unsigned)(R * K + C) * 2u; voffB[i] = (unsigned)(Rb * K + C) * 2u; RA[i] = R; CA[i] = C; }
    const size_t kstep = (size_t)(BK * 2);
    const size_t hstep = (size_t)HALF * K * 2;
    const size_t hstepA = GATHER ? (size_t)0 : hstep;
    const size_t tstep = 2 * hstep;
    const unsigned ldsw = (unsigned)wid * 1024u;
    const int aoff = lds_byte(wr * 64 + fr, fq * 8), boff = lds_byte(wc * 32 + fr, fq * 8);
#define PG8_SA(b, h) (((b) * 2 + (h)) * HTB)
#define PG8_SB(b, h) ((4 + (b) * 2 + (h)) * HTB)
#define PG8_STAGE2X(bufoff, gbase, v0, v1, aux) do { \
        __builtin_amdgcn_global_load_lds((const unsigned*)((const char*)(gbase) + (v0)), (PG8_LAS unsigned*)(lds + (bufoff) + ldsw), 16, 0, aux); \
        __builtin_amdgcn_global_load_lds((const unsigned*)((const char*)(gbase) + (v1)), (PG8_LAS unsigned*)(lds + (bufoff) + ldsw + 8192), 16, 0, aux); } while (0)
#define PG8_STAGE2(bufoff, gbase, v0, v1) PG8_STAGE2X(bufoff, gbase, v0, v1, 0)
#define PG8_STAGE(bufoff, gbase, voff) PG8_STAGE2(bufoff, gbase, (voff)[0], (voff)[1])
#define PG8_STAGE_A(bufoff, gbase, g0, g1) do { if constexpr (GATHER) PG8_STAGE2(bufoff, gbase, g0, g1); else if constexpr (Sched::A_SC1) PG8_STAGE2X(bufoff, gbase, voffA[0], voffA[1], 16); else PG8_STAGE2(bufoff, gbase, voffA[0], voffA[1]); } while (0)
#define PG8_LDA(dst, b, h) do { _Pragma("unroll") for (int m = 0; m < 4; ++m) _Pragma("unroll") for (int k = 0; k < 2; ++k) dst[m][k] = *(const PG8_LAS bf16x8*)(lds + PG8_SA(b, h) + aoff + m * 2048 + k * 1024); } while (0)
#define PG8_LDB(dst, b, h) do { _Pragma("unroll") for (int n = 0; n < 2; ++n) _Pragma("unroll") for (int k = 0; k < 2; ++k) dst[n][k] = *(const PG8_LAS bf16x8*)(lds + PG8_SB(b, h) + boff + n * 2048 + k * 1024); } while (0)
#define PG8_MMA(ai, bj, At, Bt) do { __builtin_amdgcn_s_setprio(1); _Pragma("unroll") for (int m = 0; m < 4; ++m) _Pragma("unroll") for (int n = 0; n < 2; ++n) _Pragma("unroll") for (int k = 0; k < 2; ++k) \
        acc[ai][bj][m][n] = __builtin_amdgcn_mfma_f32_16x16x32_bf16(Bt[n][k], At[m][k], acc[ai][bj][m][n], 0, 0, 0); __builtin_amdgcn_s_setprio(0); } while (0)
#define PG8_WAIT_V(n) asm volatile("s_waitcnt vmcnt(" #n ")" ::: "memory")
#define PG8_WAIT_L(n) asm volatile("s_waitcnt lgkmcnt(" #n ")" ::: "memory")
#define PG8_BAR __builtin_amdgcn_s_barrier()
#define PG8_SCHED __builtin_amdgcn_sched_barrier(0)
    Unit cur, nxt; int ui = 0;
    if (!S.next(0, cur)) return;
    S.wait_ready(cur);
    f32x4 acc[2][2][4][2];
#pragma unroll
    for (int a = 0; a < 2; ++a)
#pragma unroll
        for (int b = 0; b < 2; ++b)
#pragma unroll
            for (int m = 0; m < 4; ++m)
#pragma unroll
                for (int n = 0; n < 2; ++n) acc[a][b][m][n] = (f32x4){0.f, 0.f, 0.f, 0.f};
    bf16x8 At[4][2], B0[2][2], B1[2][2];
    unsigned gc00 = 0u, gc01 = 0u, gc10 = 0u, gc11 = 0u, gn00 = 0u, gn01 = 0u, gn10 = 0u, gn11 = 0u;
    if constexpr (GATHER) {
        gc00 = S.goff(0, RA[0]) + (unsigned)CA[0] * 2u; gc01 = S.goff(0, RA[1]) + (unsigned)CA[1] * 2u;
        gc10 = S.goff(0, 128 + RA[0]) + (unsigned)CA[0] * 2u; gc11 = S.goff(0, 128 + RA[1]) + (unsigned)CA[1] * 2u;
    }
    const char* cA = GATHER ? (const char*)g.A : (const char*)g.A + (size_t)cur.pm * tstep; const char* cB = (const char*)g.Bt + (size_t)cur.pn * tstep;
    PG8_STAGE(PG8_SB(0, 0), cB, voffB); PG8_STAGE(PG8_SB(0, 1), cB + hstep, voffB); PG8_STAGE_A(PG8_SA(0, 0), cA, gc00, gc01); PG8_STAGE_A(PG8_SA(0, 1), cA + hstepA, gc10, gc11);
    if (wr == 1) PG8_BAR;
    PG8_WAIT_V(2); PG8_BAR;
    PG8_STAGE(PG8_SB(1, 0), cB + kstep, voffB); PG8_STAGE_A(PG8_SA(1, 0), cA + kstep, gc00, gc01); PG8_STAGE(PG8_SB(1, 1), cB + hstep + kstep, voffB);
    PG8_WAIT_V(6); PG8_BAR;
    for (;;) {
        const bool has_next = S.next(ui + 1, nxt);
        if (has_next) S.wait_ready(nxt);
        const char* nA = GATHER ? (const char*)g.A : (has_next ? (const char*)g.A + (size_t)nxt.pm * tstep : cA); const char* nB = has_next ? (const char*)g.Bt + (size_t)nxt.pn * tstep : cB;
        if constexpr (GATHER) {
            if (has_next) { gn00 = S.goff(ui + 1, RA[0]) + (unsigned)CA[0] * 2u; gn01 = S.goff(ui + 1, RA[1]) + (unsigned)CA[1] * 2u;
                            gn10 = S.goff(ui + 1, 128 + RA[0]) + (unsigned)CA[0] * 2u; gn11 = S.goff(ui + 1, 128 + RA[1]) + (unsigned)CA[1] * 2u; }
            else { gn00 = gc00; gn01 = gc01; gn10 = gc10; gn11 = gc11; }
        }
        const bool halfu = GATHER_OR_MOE ? (cur.h != 0) : false;
        for (int t = 0; t < nt; t += 2) {
            const bool last = (t == nt - 2);
            const char* a1 = cA + (size_t)(t + 1) * kstep;
            const char* a2 = last ? nA : cA + (size_t)(t + 2) * kstep; const char* b2 = last ? nB : cB + (size_t)(t + 2) * kstep;
            const char* a3 = a2 + kstep; const char* b3 = b2 + kstep;
            unsigned s00 = 0u, s01 = 0u, s10 = 0u, s11 = 0u;
            if constexpr (GATHER) { s00 = last ? gn00 : gc00; s01 = last ? gn01 : gc01; s10 = last ? gn10 : gc10; s11 = last ? gn11 : gc11; }
            PG8_LDB(B0, 0, 0); PG8_LDB(B1, 0, 1); PG8_SCHED; PG8_LDA(At, 0, 0); PG8_STAGE_A(PG8_SA(1, 1), a1 + hstepA, gc10, gc11);
            PG8_WAIT_V(8); PG8_WAIT_L(0); PG8_BAR; PG8_MMA(0, 0, At, B0); PG8_MMA(0, 1, At, B1); PG8_BAR; PG8_SCHED;
            if (!halfu) PG8_LDA(At, 0, 1); PG8_STAGE(PG8_SB(0, 0), b2, voffB); PG8_STAGE(PG8_SB(0, 1), b2 + hstep, voffB); PG8_STAGE_A(PG8_SA(0, 0), a2, s00, s01);
            PG8_WAIT_V(8); PG8_WAIT_L(0); PG8_BAR; if (!halfu) { PG8_MMA(1, 0, At, B0); PG8_MMA(1, 1, At, B1); } PG8_BAR; PG8_SCHED;
            PG8_LDB(B0, 1, 0); PG8_LDB(B1, 1, 1); PG8_SCHED; PG8_LDA(At, 1, 0); PG8_STAGE_A(PG8_SA(0, 1), a2 + hstepA, s10, s11);
            PG8_WAIT_V(8); PG8_WAIT_L(0); PG8_BAR; PG8_MMA(0, 0, At, B0); PG8_MMA(0, 1, At, B1); PG8_BAR; PG8_SCHED;
            if (!halfu) PG8_LDA(At, 1, 1); PG8_STAGE(PG8_SB(1, 0), b3, voffB); PG8_STAGE(PG8_SB(1, 1), b3 + hstep, voffB); PG8_STAGE_A(PG8_SA(1, 0), a3, s00, s01);
            PG8_WAIT_V(8); PG8_WAIT_L(0); PG8_BAR; if (!halfu) { PG8_MMA(1, 0, At, B0); PG8_MMA(1, 1, At, B1); } PG8_BAR; PG8_SCHED;
        }
        if (wr == 0) PG8_BAR;
        E(acc, cur, ui, wr, wc, fr, fq);
        if (!has_next) break;
#pragma unroll
        for (int a = 0; a < 2; ++a)
#pragma unroll
            for (int b = 0; b < 2; ++b)
#pragma unroll
                for (int m = 0; m < 4; ++m)
#pragma unroll
                    for (int n = 0; n < 2; ++n) acc[a][b][m][n] = (f32x4){0.f, 0.f, 0.f, 0.f};
        cur = nxt; cA = nA; cB = nB; ++ui;
        if constexpr (GATHER) { gc00 = gn00; gc01 = gn01; gc10 = gn10; gc11 = gn11; }
        if (wr == 1) PG8_BAR;
    }
    PG8_WAIT_V(0);
    PG8_BAR;
#undef PG8_SA
#undef PG8_SB
#undef PG8_STAGE
#undef PG8_STAGE2
#undef PG8_STAGE2X
#undef PG8_STAGE_A
#undef PG8_LDA
#undef PG8_LDB
#undef PG8_MMA
#undef PG8_WAIT_V
#undef PG8_WAIT_L
#undef PG8_BAR
#undef PG8_SCHED
}
}

#define XB_TMO      128
#define XB_XCNT(j)  (256  + 64 * (j))
#define XB_XSUB(j)  (1280 + 64 * (j))
#define XB_XGEN(j)  (2304 + 64 * (j))
#define XB_TOP      3328
#define XB_TOPGEN   3392
#define XCD_BAR_WORDS 3456
#define XB_SPIN_CAP (1u << 18)

__device__ __forceinline__ unsigned xb_ld(unsigned* p)              { return __hip_atomic_load(p, __ATOMIC_RELAXED, __HIP_MEMORY_SCOPE_AGENT); }
__device__ __forceinline__ unsigned xb_add(unsigned* p, unsigned v) { return __hip_atomic_fetch_add(p, v, __ATOMIC_RELAXED, __HIP_MEMORY_SCOPE_AGENT); }
__device__ __forceinline__ unsigned xb_xcc_id() { return (unsigned)__builtin_amdgcn_s_getreg((3 << 11) | 20) & 0xFu; }
#define XB_SPIN(cond, bar) do { unsigned _sp = 0; while (cond) { __builtin_amdgcn_s_sleep(1); \
    if ((++_sp & 255u) == 0u) { if (xb_ld(&(bar)[XB_TMO])) break; if (_sp > XB_SPIN_CAP) { atomicAdd(&(bar)[XB_TMO], 1u); break; } } } } while (0)

struct XcdBarrier {
    unsigned* bar; unsigned x;
    volatile LAS unsigned* st;
};

__device__ __forceinline__ XcdBarrier xcd_barrier_post(unsigned* bar, volatile LAS unsigned* st) {
    XcdBarrier b; b.bar = bar; b.x = xb_xcc_id(); b.st = st;
    if (threadIdx.x == 0) (void)xb_add(&bar[XB_XCNT(b.x)], 1u);
    return b;
}
__device__ __forceinline__ void xcd_barrier_complete(unsigned* bar, unsigned x, unsigned& nloc, unsigned& nx) {
    const unsigned G = gridDim.x * gridDim.y * gridDim.z;
    unsigned sum, cnt, mine, sp = 0u;
    for (;;) {
        sum = 0u; cnt = 0u; mine = 0u;
#pragma unroll
        for (unsigned j = 0; j < 16; ++j) { const unsigned c = xb_ld(&bar[XB_XCNT(j)]); sum += c; cnt += (c > 0u) ? 1u : 0u; mine = (j == x) ? c : mine; }
        if (sum == G) break;
        __builtin_amdgcn_s_sleep(1);
        if ((++sp & 255u) == 0u) { if (xb_ld(&bar[XB_TMO])) break; if (sp > XB_SPIN_CAP) { atomicAdd(&bar[XB_TMO], 1u); break; } }
    }
    nloc = mine > 0u ? mine : 1u; nx = cnt > 0u ? cnt : 1u;
}

__device__ __forceinline__ void xcd_barrier(const XcdBarrier& b) {
    asm volatile("s_waitcnt vmcnt(0)" ::: "memory");
    __syncthreads();
    if (threadIdx.x == 0) {
        unsigned* bar = b.bar;
        __builtin_amdgcn_s_waitcnt(0);
        unsigned nloc = b.st[0], nx = b.st[1];
        if (nloc == 0u) { xcd_barrier_complete(bar, b.x, nloc, nx); b.st[0] = nloc; b.st[1] = nx; }
        const unsigned old = xb_add(&bar[XB_XSUB(b.x)], 1u);
        const unsigned gen = old / nloc;
        if (old + 1u == (gen + 1u) * nloc) {
            __builtin_amdgcn_fence(__ATOMIC_RELEASE, "agent");
            asm volatile("s_waitcnt vmcnt(0)" ::: "memory");
            const unsigned og = xb_add(&bar[XB_TOP], 1u);
            const unsigned tg = og / nx;
            if (og + 1u == (tg + 1u) * nx) xb_add(&bar[XB_TOPGEN], 1u);
            else XB_SPIN(xb_ld(&bar[XB_TOPGEN]) == tg, bar);
            __builtin_amdgcn_fence(__ATOMIC_ACQUIRE, "agent");
            xb_add(&bar[XB_XGEN(b.x)], 1u);
            asm volatile("s_waitcnt vmcnt(0)" ::: "memory");
        } else {
            XB_SPIN(xb_ld(&bar[XB_XGEN(b.x)]) == gen, bar);
            __builtin_amdgcn_fence(__ATOMIC_ACQUIRE, "agent");
            asm volatile("s_waitcnt vmcnt(0)" ::: "memory");
        }
    }
    __syncthreads();
}

constexpr size_t MiB = 1u << 20;
constexpr size_t WS_CTL = 0, CTL_ZERO_BYTES = MiB / 4;
constexpr size_t WS_MOD = 1 * MiB;
constexpr size_t WS_KVMOD = WS_MOD + (size_t)4 * 4 * 6144 * 4;
constexpr size_t WS_BIASA = 2 * MiB;
constexpr size_t WS_BIASB = WS_BIASA + (size_t)8 * 4224 * 4;
constexpr size_t WS_LAM = WS_BIASB + (size_t)3 * 8 * 224 * 4;
constexpr size_t WS_UTAB = WS_LAM + 64;
constexpr size_t WS_RWT = 7 * MiB;
constexpr size_t WS_ROWTOK = 3 * MiB;
constexpr size_t WS_ROWW = 5 * MiB;
constexpr size_t WS_WQKVA = 8 * MiB;
constexpr size_t WS_WOA = 20 * MiB;
constexpr size_t WS_WKV = 24 * MiB;
constexpr size_t WS_WQB = 30 * MiB;
constexpr size_t WS_WOB = 36 * MiB;
constexpr size_t WS_MGU = 40 * MiB;
constexpr size_t WS_MDN = 296 * MiB;
constexpr size_t WS_HN = 424 * MiB;
constexpr size_t WS_HKV = 456 * MiB;
constexpr size_t WS_QA = 488 * MiB, WS_KA = 520 * MiB, WS_VA = 552 * MiB;
constexpr size_t WS_OA = 584 * MiB;
constexpr size_t WS_QB = 488 * MiB;
constexpr size_t WS_OG = 536 * MiB;
constexpr size_t WS_OB = 584 * MiB;
constexpr size_t WS_LSE = 600 * MiB;
constexpr size_t WS_KS = 616 * MiB, WS_VS = 664 * MiB;
constexpr size_t WS_ACT = 712 * MiB;
constexpr size_t WS_YB = 754 * MiB;
constexpr size_t WS_LLT = 1000 * MiB;
constexpr size_t WS_LLW = 1004 * MiB;
constexpr size_t WS_CNT = 1008 * MiB;
constexpr size_t WS_X = 940 * MiB;
constexpr size_t WS_PROBE = 820 * MiB;
constexpr size_t WS_END = 972 * MiB;

constexpr int CW_TMO = 0, CW_CODE = 1;
constexpr int CW_BAR = 4096;
constexpr int CW_GCNT = 8192;
constexpr int CW_XP = 24576;
constexpr int CW_ACT = 32768;
static_assert((CW_GCNT + 8 * 2048) <= CW_ACT && (CW_ACT + 8 * 160 * 16) * 4 <= (int)CTL_ZERO_BYTES, "ctl");

constexpr int RING_BYTES = 131072;
constexpr int SCR_BYTES = 147456;
constexpr int LDSCTL_OFF = SCR_BYTES, MISC_OFF = LDSCTL_OFF + 64;
constexpr int TOKL_OFF = LDSCTL_OFF + 256;
constexpr int WL_OFF = TOKL_OFF + 4096;
constexpr int MT_OFF = WL_OFF + 4096;
constexpr int ULIST_OFF = MT_OFF + 512;
constexpr int HIST_OFF = ULIST_OFF + 256;
constexpr int REC_OFF = HIST_OFF + 256;
constexpr int LDS_BYTES = 163840;
constexpr int TOKL2_OFF = REC_OFF;
static_assert(REC_OFF + 128 * 32 <= LDS_BYTES, "LDS map");

struct Frame {
    LAS unsigned char* lds;
    int tid, lane, wave, vcu, G;
    unsigned char* ws;
};
__device__ __forceinline__ int tid_fresh() { int t = threadIdx.x; asm volatile("" : "+v"(t)); return t; }

__device__ __forceinline__ float wave_sum(float v) {
    v += __builtin_bit_cast(float, __builtin_amdgcn_update_dpp(0, __builtin_bit_cast(int, v), 0xB1, 0xF, 0xF, true));
    v += __builtin_bit_cast(float, __builtin_amdgcn_update_dpp(0, __builtin_bit_cast(int, v), 0x4E, 0xF, 0xF, true));
    v += __builtin_bit_cast(float, __builtin_amdgcn_update_dpp(0, __builtin_bit_cast(int, v), 0x141, 0xF, 0xF, true));
    v += __builtin_bit_cast(float, __builtin_amdgcn_update_dpp(0, __builtin_bit_cast(int, v), 0x140, 0xF, 0xF, true));
    const int i = __builtin_bit_cast(int, v);
    const float s0 = __builtin_bit_cast(float, __builtin_amdgcn_readlane(i, 0)), s1 = __builtin_bit_cast(float, __builtin_amdgcn_readlane(i, 16));
    const float s2 = __builtin_bit_cast(float, __builtin_amdgcn_readlane(i, 32)), s3 = __builtin_bit_cast(float, __builtin_amdgcn_readlane(i, 48));
    return (s0 + s1) + (s2 + s3);
}

__device__ __forceinline__ float wave_max(float v) {
    v = fmaxf(v, __builtin_bit_cast(float, __builtin_amdgcn_update_dpp(__builtin_bit_cast(int, v), __builtin_bit_cast(int, v), 0xB1, 0xF, 0xF, false)));
    v = fmaxf(v, __builtin_bit_cast(float, __builtin_amdgcn_update_dpp(__builtin_bit_cast(int, v), __builtin_bit_cast(int, v), 0x4E, 0xF, 0xF, false)));
    v = fmaxf(v, __builtin_bit_cast(float, __builtin_amdgcn_update_dpp(__builtin_bit_cast(int, v), __builtin_bit_cast(int, v), 0x141, 0xF, 0xF, false)));
    v = fmaxf(v, __builtin_bit_cast(float, __builtin_amdgcn_update_dpp(__builtin_bit_cast(int, v), __builtin_bit_cast(int, v), 0x140, 0xF, 0xF, false)));
    const int i = __builtin_bit_cast(int, v);
    const float s0 = __builtin_bit_cast(float, __builtin_amdgcn_readlane(i, 0)), s1 = __builtin_bit_cast(float, __builtin_amdgcn_readlane(i, 16));
    const float s2 = __builtin_bit_cast(float, __builtin_amdgcn_readlane(i, 32)), s3 = __builtin_bit_cast(float, __builtin_amdgcn_readlane(i, 48));
    return fmaxf(fmaxf(s0, s1), fmaxf(s2, s3));
}

__device__ __forceinline__ float quad16_sum(float v) {
    float a = v, b = v; asm volatile("s_nop 1\n\tv_permlane16_swap_b32_e32 %0, %1\n\ts_nop 1" : "+v"(a), "+v"(b)); v = a + b;
    a = v; b = v; asm volatile("s_nop 1\n\tv_permlane32_swap_b32_e32 %0, %1\n\ts_nop 1" : "+v"(a), "+v"(b)); return a + b;
}

__device__ __forceinline__ int t5_bucket(int n) {
    if (n < 16) return n;
    return 16 + (n >= 22) + (n >= 30) + (n >= 40) + (n >= 54) + (n >= 73) + (n >= 99) + (n >= 134) + (n >= 182) + (n >= 246) + (n >= 332) + (n >= 450) + (n >= 609) + (n >= 825) + (n >= 1117) + (n >= 1513);
}

__device__ __forceinline__ void p0_transpose_item(const float* W, int K, int N, bf16* WT, int k0, int n0, int orow0, LAS float* scr, int lane) {
#pragma unroll 8
    for (int i = 0; i < 32; ++i) { const int kk = 2 * i + (lane >> 5); scr[kk * 33 + (lane & 31)] = W[(size_t)(k0 + kk) * N + n0 + (lane & 31)]; }
    LDS_WAIT(); asm volatile("" ::: "memory");
    const int c = lane & 7;
#pragma unroll
    for (int j = 0; j < 4; ++j) { const int n = (lane >> 3) + 8 * j; const LAS float* s = scr + (8 * c) * 33 + n;
        v4u o; o.x = cvt_pk_bf16(s[0 * 33], s[1 * 33]); o.y = cvt_pk_bf16(s[2 * 33], s[3 * 33]); o.z = cvt_pk_bf16(s[4 * 33], s[5 * 33]); o.w = cvt_pk_bf16(s[6 * 33], s[7 * 33]);
        *(GAS v4u*)(WT + (size_t)(orow0 + n) * K + k0 + 8 * c) = o; }
    LDS_WAIT(); asm volatile("" ::: "memory");
}
__device__ __forceinline__ void p0_transpose_item64(const float* W, int K, int N, bf16* WT, int k0, int n0, int orow0, LAS float* scr, int lane) {
    const int kk = lane >> 4, n4 = (lane & 15) * 4;
    f32x4 v[16];
#pragma unroll
    for (int i = 0; i < 16; ++i) v[i] = *(const GAS f32x4*)(W + (size_t)(k0 + 4 * i + kk) * N + n0 + n4);
#pragma unroll
    for (int i = 0; i < 16; ++i) { LAS float* d = scr + (4 * i + kk) * 65 + n4; d[0] = v[i].x; d[1] = v[i].y; d[2] = v[i].z; d[3] = v[i].w; }
    LDS_WAIT(); asm volatile("" ::: "memory");
    const int c = lane & 7;
#pragma unroll
    for (int j = 0; j < 8; ++j) { const int n = (lane >> 3) + 8 * j; const LAS float* s = scr + (8 * c) * 65 + n;
        v4u o; o.x = cvt_pk_bf16(s[0 * 65], s[1 * 65]); o.y = cvt_pk_bf16(s[2 * 65], s[3 * 65]); o.z = cvt_pk_bf16(s[4 * 65], s[5 * 65]); o.w = cvt_pk_bf16(s[6 * 65], s[7 * 65]);
        *(GAS v4u*)(WT + (size_t)(orow0 + n) * K + k0 + 8 * c) = o; }
    LDS_WAIT(); asm volatile("" ::: "memory");
}
constexpr int MOE_ITEMS64 = 32 * 384;
__device__ __forceinline__ void moe_item64(unsigned char* ws, const float* wgate, const float* wup, const float* wdown, int lyr, int it, LAS float* scr, int lane) {
    const int le = lyr * 32 + it / 384; int r = it % 384;
    if (r < 256) { const int up = r >> 7; r &= 127; const int kb = r / 8, nb = r % 8, n0 = nb * 64;
        p0_transpose_item64((up ? wup : wgate) + (size_t)le * 1024 * 512, 1024, 512, (bf16*)(ws + WS_MGU) + (size_t)le * 1024 * 1024, kb * 64, n0, 256 * (n0 >> 7) + 128 * up + (n0 & 127), scr, lane); }
    else { r -= 256; const int kb = r / 16, nb = r % 16, n0 = nb * 64;
        p0_transpose_item64(wdown + (size_t)le * 512 * 1024, 512, 1024, (bf16*)(ws + WS_MDN) + (size_t)le * 1024 * 512, kb * 64, n0, n0, scr, lane); }
}
constexpr int HELP_N3A = 6144;
__device__ __forceinline__ int headperm_row(int n) { const int L = n & 255; return (n & ~255) + 128 * ((L >> 5) & 1) + 32 * (L >> 6) + (L & 31); }

struct Inputs { const float* p[28]; };

template <class IT> __device__ __forceinline__ void p0_prologue(Frame& F, const IT& I) {
    LAS float* cact = (LAS float*)(F.lds);
    LAS float* red = (LAS float*)(F.lds + 16384);
    for (int i = F.tid; i < 4096; i += 512) { const float v = I.p[1][i]; cact[i] = v / (1.f + __expf(-v)); }
    __syncthreads();
    for (int it = F.vcu; it < 416; it += F.G) {
        const float* W; const float* bias; float* out; int N, nb;
        if (it < 384) { const int layer = it / 96; nb = it % 96; N = 6144; W = I.p[3] + (size_t)layer * 1024 * 6144; bias = I.p[4] + layer * 6144; out = (float*)(F.ws + WS_MOD) + layer * 4 * 6144; }
        else { nb = it - 384; N = 2048; W = I.p[14]; bias = I.p[15]; out = (float*)(F.ws + WS_KVMOD); }
        const int n = nb * 64 + F.lane, k0 = F.wave * 128;
        float a0 = 0.f, a1 = 0.f, a2 = 0.f, a3 = 0.f;
#pragma unroll 16
        for (int kk = 0; kk < 128; ++kk) { const float w = W[(size_t)(k0 + kk) * N + n]; a0 += cact[k0 + kk] * w; a1 += cact[1024 + k0 + kk] * w; a2 += cact[2048 + k0 + kk] * w; a3 += cact[3072 + k0 + kk] * w; }
        red[(F.wave * 4 + 0) * 64 + F.lane] = a0; red[(F.wave * 4 + 1) * 64 + F.lane] = a1; red[(F.wave * 4 + 2) * 64 + F.lane] = a2; red[(F.wave * 4 + 3) * 64 + F.lane] = a3;
        __syncthreads();
        if (F.wave < 4) { float s = bias[n];
#pragma unroll
            for (int w8 = 0; w8 < 8; ++w8) s += red[(w8 * 4 + F.wave) * 64 + F.lane];
            out[F.wave * N + n] = s; }
        __syncthreads();
    }
    {
        const int gt = F.vcu * 512 + F.tid, GT = F.G * 512;
        const float* rel_bias = I.p[2];
        float* ba = (float*)(F.ws + WS_BIASA);
        for (int i = gt; i < 8 * 4224; i += GT) { const int h = i / 4224, idx = i % 4224, dist = 4095 - idx; ba[i] = dist < 0 ? -INFINITY : rel_bias[t5_bucket(dist) * 8 + h] * LOG2E; }
        float* bb = (float*)(F.ws + WS_BIASB);
        for (int i = gt; i < 3 * 8 * 224; i += GT) { const int g = i / (8 * 224), h = (i / 224) % 8, idx = i % 224, rel = 159 - idx; const int dil = g == 0 ? 1 : (g == 1 ? 4 : 16);
            bb[i] = (rel < 0 || rel > 128) ? -INFINITY : rel_bias[t5_bucket(dil * rel) * 8 + h] * LOG2E; }
        unsigned short* rwt = (unsigned short*)(F.ws + WS_RWT);
        for (int i = gt; i < 4 * 36 * 1024; i += GT) { const int l = i / (36 * 1024), o = (i / 1024) % 36, k = i % 1024;
            const float w = o < 4 ? I.p[21][(size_t)l * 4096 + k * 4 + o] : I.p[23][(size_t)l * 32768 + k * 32 + (o - 4)];
            const unsigned hi = cvtpk_s(w, 0.f) & 0xffffu, lo = cvtpk_s(w - bf_lo(hi), 0.f) & 0xffffu;
            const int pos = o * 1024 + ((((k >> 3) ^ (o & 15)) << 3) | (k & 7));
            rwt[(size_t)l * 73728 + pos] = (unsigned short)hi; rwt[(size_t)l * 73728 + 36864 + pos] = (unsigned short)lo; }
        float* ut = (float*)(F.ws + WS_UTAB);
        for (int i = gt; i < 8 * 128; i += GT) { const int h = i >> 7, j = i & 127, d0 = 32 * j - 63;
            ut[i] = (d0 >= 0 && t5_bucket(d0) == t5_bucket(d0 + 94)) ? rel_bias[t5_bucket(d0) * 8 + h] * LOG2E : __builtin_nanf(""); }
        if (F.vcu == 1 && F.wave < 6) {
            const int J = F.wave / 3, g = F.wave % 3;
            const float gq = wave_max(fabsf(I.p[19][(J * 3 + g) * 64 + F.lane])), gk = wave_max(fabsf(I.p[17][g * 64 + F.lane]));
            const float bm = wave_max(fmaxf(fmaxf(rel_bias[F.lane], rel_bias[64 + F.lane]), fmaxf(rel_bias[128 + F.lane], rel_bias[192 + F.lane]))) * LOG2E;
            if (F.lane == 0) ((float*)(F.ws + WS_LAM))[4 + F.wave] = fmaxf(0.f, 64.f * QSCALE * gq * gk + bm - 24.f);
        }
        if (F.vcu == 0 && F.wave < 2) {
            const float* lp = I.p[10] + F.wave * 4 * 64;
            const float s1 = wave_sum(lp[F.lane] * lp[64 + F.lane]), s2 = wave_sum(lp[128 + F.lane] * lp[192 + F.lane]);
            const float lam_init = 0.8f - 0.6f * expf(-0.3f * (float)F.wave);
            if (F.lane == 0) ((float*)(F.ws + WS_LAM))[F.wave] = expf(s1) - expf(s2) + lam_init;
            const float gq = wave_max(fabsf(I.p[8][F.wave * 64 + F.lane])), gk = wave_max(fabsf(I.p[9][F.wave * 64 + F.lane]));
            const float bm = wave_max(fmaxf(fmaxf(rel_bias[F.lane], rel_bias[64 + F.lane]), fmaxf(rel_bias[128 + F.lane], rel_bias[192 + F.lane]))) * LOG2E;
            if (F.lane == 0) ((float*)(F.ws + WS_LAM))[2 + F.wave] = fmaxf(0.f, 64.f * QSCALE * gq * gk + bm - 24.f);
        }
    }
    __syncthreads();
    LAS float* scr = (LAS float*)(F.lds + F.wave * 16384);
    const int gw = F.vcu * 8 + F.wave, NGW = F.G * 8;
    constexpr int I_QKVA = 16 * 96, I_OA = 16 * 32, I_KV = 16 * 96, I_QB = 16 * 48, I_OB = 8 * 32;
    constexpr int N_DENSE = 2 * I_QKVA + 2 * I_OA + I_KV + 2 * I_QB + 2 * I_OB;
    for (int it = gw; it < N_DENSE; it += NGW) {
        int r = it;
        if (r < 2 * I_QKVA) { const int l = r / I_QKVA; r %= I_QKVA; const int kb = r / 96, nb = r % 96, n0 = nb * 32;
            p0_transpose_item(I.p[7] + (size_t)l * 1024 * 3072, 1024, 3072, (bf16*)(F.ws + WS_WQKVA) + (size_t)l * 3072 * 1024, kb * 64, n0, headperm_row(n0), scr, F.lane); continue; } r -= 2 * I_QKVA;
        if (r < 2 * I_OA) { const int l = r / I_OA; r %= I_OA; const int kb = r / 32, nb = r % 32, n0 = nb * 32;
            p0_transpose_item(I.p[12] + (size_t)l * 1024 * 1024, 1024, 1024, (bf16*)(F.ws + WS_WOA) + (size_t)l * 1024 * 1024, kb * 64, n0, n0, scr, F.lane); continue; } r -= 2 * I_OA;
        if (r < I_KV) { const int kb = r / 96, nb = r % 96, n0 = nb * 32;
            p0_transpose_item(I.p[16], 1024, 3072, (bf16*)(F.ws + WS_WKV), kb * 64, n0, headperm_row(n0), scr, F.lane); continue; } r -= I_KV;
        if (r < 2 * I_QB) { const int l = r / I_QB; r %= I_QB; const int kb = r / 48, nb = r % 48, n0 = nb * 32;
            p0_transpose_item(I.p[18] + (size_t)l * 1024 * 1536, 1024, 1536, (bf16*)(F.ws + WS_WQB) + (size_t)l * 1536 * 1024, kb * 64, n0, headperm_row(n0), scr, F.lane); continue; } r -= 2 * I_QB;
        { const int l = r / I_OB; r %= I_OB; const int kb = r / 32, nb = r % 32, n0 = nb * 32;
            p0_transpose_item(I.p[20] + (size_t)l * 512 * 1024, 512, 1024, (bf16*)(F.ws + WS_WOB) + (size_t)l * 1024 * 512, kb * 64, n0, n0, scr, F.lane); }
    }
    for (int it = gw; it < 64 * 768; it += NGW) {
        const int le = it / 768; int r = it % 768;
        if (r < 512) { const int up = r >> 8; r &= 255; const int kb = r / 16, nb = r % 16, n0 = nb * 32;
            p0_transpose_item(I.p[25 + up] + (size_t)le * 1024 * 512, 1024, 512, (bf16*)(F.ws + WS_MGU) + (size_t)le * 1024 * 1024, kb * 64, n0, 256 * (n0 >> 7) + 128 * up + (n0 & 127), scr, F.lane); }
        else { r -= 512; const int kb = r / 32, nb = r % 32, n0 = nb * 32;
            p0_transpose_item(I.p[27] + (size_t)le * 512 * 1024, 512, 1024, (bf16*)(F.ws + WS_MDN) + (size_t)le * 1024 * 512, kb * 64, n0, n0, scr, F.lane); }
    }
}

template <bool XF32> __device__ __forceinline__ void norm_phase(Frame& F, const void* xin_, bf16* xout, const bf16* yb, const float* ygate, const float* gain, const float* shift, const float* scale, int mstride, bf16* hn,
                                            const float* gain2, const float* shift2, const float* scale2, int mstride2, bf16* hn2) {
    const int gw = F.vcu * 8 + F.wave, NGW = F.G * 8;
    for (int row = gw; row < T; row += NGW) {
        const int b = row >> 12;
        f32x4 v[4]; float ss = 0.f;
#pragma unroll
        for (int j = 0; j < 4; ++j) {
            if (XF32) v[j] = *(const GAS f32x4*)((const float*)xin_ + (size_t)row * D + 4 * F.lane + 256 * j);
            else { const v2u xb = *(const GAS v2u*)((const bf16*)xin_ + (size_t)row * D + 4 * F.lane + 256 * j); v[j] = (f32x4){bf_lo(xb.x), bf_hi(xb.x), bf_lo(xb.y), bf_hi(xb.y)}; } }
        if (yb) {
#pragma unroll
            for (int j = 0; j < 4; ++j) { const v2u y0 = *(const GAS v2u*)(yb + (size_t)row * 2048 + 4 * F.lane + 256 * j), y1 = *(const GAS v2u*)(yb + (size_t)row * 2048 + 1024 + 4 * F.lane + 256 * j);
                const f32x4 gf = *(const GAS f32x4*)(ygate + b * 6144 + 4 * F.lane + 256 * j);
                v[j].x += gf.x * (bf_lo(y0.x) + bf_lo(y1.x)); v[j].y += gf.y * (bf_hi(y0.x) + bf_hi(y1.x)); v[j].z += gf.z * (bf_lo(y0.y) + bf_lo(y1.y)); v[j].w += gf.w * (bf_hi(y0.y) + bf_hi(y1.y)); }
        }
        if (xout) {
#pragma unroll
            for (int j = 0; j < 4; ++j) { v2u xb; xb.x = cvt_pk_bf16(v[j].x, v[j].y); xb.y = cvt_pk_bf16(v[j].z, v[j].w); *(GAS v2u*)(xout + (size_t)row * D + 4 * F.lane + 256 * j) = xb;
                v[j] = (f32x4){bf_lo(xb.x), bf_hi(xb.x), bf_lo(xb.y), bf_hi(xb.y)}; }
        }
#pragma unroll
        for (int j = 0; j < 4; ++j) ss += (v[j].x * v[j].x + v[j].y * v[j].y) + (v[j].z * v[j].z + v[j].w * v[j].w);
        const float rinv = __builtin_amdgcn_rsqf(wave_sum(ss) * (1.f / D) + EPS);
        if (hn) {
#pragma unroll
            for (int j = 0; j < 4; ++j) { const int c = 4 * F.lane + 256 * j;
                const f32x4 g = *(const GAS f32x4*)(gain + c), sc = *(const GAS f32x4*)(scale + b * mstride + c), sh = *(const GAS f32x4*)(shift + b * mstride + c);
                const f32x4 h = v[j] * rinv * g * (sc + 1.f) + sh;
                v2u o; o.x = cvt_pk_bf16(h.x, h.y); o.y = cvt_pk_bf16(h.z, h.w); *(GAS v2u*)(hn + (size_t)row * D + c) = o; }
        }
        if (hn2) {
#pragma unroll
            for (int j = 0; j < 4; ++j) { const int c = 4 * F.lane + 256 * j;
                const f32x4 g = *(const GAS f32x4*)(gain2 + c), sc = *(const GAS f32x4*)(scale2 + b * mstride2 + c), sh = *(const GAS f32x4*)(shift2 + b * mstride2 + c);
                const f32x4 h = v[j] * rinv * g * (sc + 1.f) + sh;
                v2u o; o.x = cvt_pk_bf16(h.x, h.y); o.y = cvt_pk_bf16(h.z, h.w); *(GAS v2u*)(hn2 + (size_t)row * D + c) = o; }
        }
    }
}

__device__ __forceinline__ void router_phase(Frame& F, const bf16* x, int rowblk, gu32* xcnt, gu32* tmo, const float* gain, const float* shift, const float* scale, bf16* hn,
                                              const float* wT, const float* bg, const float* be, gu32* gcnt, int* rowtok, float* roww) {
    LAS char* wl = (LAS char*)(F.lds);
    LAS float* AS = (LAS float*)(F.lds + TOKL_OFF);
    LAS int* lcnt = (LAS int*)(F.lds + HIST_OFF);
    LAS float* ssx = (LAS float*)(F.lds + REC_OFF);
    LAS float* lbias = (LAS float*)(F.lds + MT_OFF);
    { f32x4 tw[18];
#pragma unroll
      for (int i = 0; i < 18; ++i) tw[i] = *(const GAS f32x4*)(wT + 4 * (F.tid + 512 * i));
#pragma unroll
      for (int i = 0; i < 18; ++i) *(LAS f32x4*)((LAS float*)wl + 4 * (F.tid + 512 * i)) = tw[i]; }
    if (F.tid < 64) lcnt[F.tid] = 0;
    if (F.tid < 4) lbias[F.tid] = bg[F.tid]; else if (F.tid < 36) lbias[F.tid] = be[F.tid - 4];
    const int b = (rowblk * 64) >> 12;
    if (F.tid < 256) { const int c = 4 * F.tid;
        const f32x4 g = *(const GAS f32x4*)(gain + c), sc = *(const GAS f32x4*)(scale + b * 6144 + c);
        *(LAS f32x4*)(AS + c) = g * (sc + 1.f); *(LAS f32x4*)(AS + 1024 + c) = *(const GAS f32x4*)(shift + b * 6144 + c); }
    if (xcnt) {
        gu32* c = xcnt + (rowblk >> 2) * 16; unsigned sp = 0;
        while (__hip_atomic_load(c, RLX_AGENT) < 32u) { __builtin_amdgcn_s_sleep(2);
            if ((++sp & 63u) == 0u) { if (__hip_atomic_load(tmo, RLX_AGENT) != 0u) break; if (sp > (1u << 17)) { __hip_atomic_store(tmo, 0xACEu, RLX_AGENT); break; } } }
    }
    const int mt = F.wave & 3, kh = F.wave >> 2, li = F.lane & 15, kq = F.lane >> 4;
    const int row = rowblk * 64 + mt * 16 + li, kbase = 512 * kh + 8 * kq;
    const __amdgpu_buffer_rsrc_t xrs = __builtin_amdgcn_make_buffer_rsrc((void*)x, 0, 32 << 20, 0x00020000);
    v4u xr[16];
#pragma unroll
    for (int s = 0; s < 16; ++s) xr[s] = __builtin_bit_cast(v4u, __builtin_amdgcn_raw_buffer_load_b128(xrs, (unsigned)(row * D + kbase + 32 * s) * 2u, 0, 16));
    float ss = 0.f;
#pragma unroll
    for (int s = 0; s < 16; ++s) { const v4u q = xr[s];
        const float a0 = bf_lo(q.x), a1 = bf_hi(q.x), a2 = bf_lo(q.y), a3 = bf_hi(q.y), a4 = bf_lo(q.z), a5 = bf_hi(q.z), a6 = bf_lo(q.w), a7 = bf_hi(q.w);
        ss += ((a0 * a0 + a1 * a1) + (a2 * a2 + a3 * a3)) + ((a4 * a4 + a5 * a5) + (a6 * a6 + a7 * a7)); }
    ss += __builtin_bit_cast(float, __builtin_amdgcn_ds_bpermute((F.lane ^ 16) << 2, __builtin_bit_cast(int, ss)));
    ss += __builtin_bit_cast(float, __builtin_amdgcn_ds_bpermute((F.lane ^ 32) << 2, __builtin_bit_cast(int, ss)));
    if (kq == 0) ssx[F.wave * 16 + li] = ss;
    __syncthreads();
    const float rinv = __builtin_amdgcn_rsqf((ssx[F.wave * 16 + li] + ssx[(F.wave ^ 4) * 16 + li]) * (1.f / D) + EPS);
    f32x4 acc[3];
#pragma unroll
    for (int n = 0; n < 3; ++n) acc[n] = (f32x4){0.f, 0.f, 0.f, 0.f};
    int wrow[3];
#pragma unroll
    for (int n = 0; n < 3; ++n) { const int o = (16 * n + li) > 35 ? 35 : (16 * n + li); wrow[n] = o * 2048; }
    bf16* hrow = hn + (size_t)row * D + kbase;
#pragma unroll
    for (int s = 0; s < 16; ++s) {
        const int k0 = kbase + 32 * s, chunk = (64 * kh + 4 * s + kq) ^ li;
        const f32x4 A0 = *(const LAS f32x4*)(AS + k0), A1 = *(const LAS f32x4*)(AS + k0 + 4), S0 = *(const LAS f32x4*)(AS + 1024 + k0), S1 = *(const LAS f32x4*)(AS + 1024 + k0 + 4);
        const v4u q = xr[s];
        const f32x4 h0 = (f32x4){bf_lo(q.x), bf_hi(q.x), bf_lo(q.y), bf_hi(q.y)} * rinv * A0 + S0, h1 = (f32x4){bf_lo(q.z), bf_hi(q.z), bf_lo(q.w), bf_hi(q.w)} * rinv * A1 + S1;
        v4u hw; hw.x = cvt_pk_bf16(h0.x, h0.y); hw.y = cvt_pk_bf16(h0.z, h0.w); hw.z = cvt_pk_bf16(h1.x, h1.y); hw.w = cvt_pk_bf16(h1.z, h1.w);
        *(GAS v4u*)(hrow + 32 * s) = hw;
        v4u lw; lw.x = cvt_pk_bf16(h0.x - bf_lo(hw.x), h0.y - bf_hi(hw.x)); lw.y = cvt_pk_bf16(h0.z - bf_lo(hw.y), h0.w - bf_hi(hw.y));
        lw.z = cvt_pk_bf16(h1.x - bf_lo(hw.z), h1.y - bf_hi(hw.z)); lw.w = cvt_pk_bf16(h1.z - bf_lo(hw.w), h1.w - bf_hi(hw.w));
        const bf16x8 ah = __builtin_bit_cast(bf16x8, hw), al = __builtin_bit_cast(bf16x8, lw);
#pragma unroll
        for (int n = 0; n < 3; ++n) { const LAS char* wp = wl + wrow[n] + chunk * 16;
            const bf16x8 bh = *(const LAS bf16x8*)(wp), bl = *(const LAS bf16x8*)(wp + 73728);
            acc[n] = __builtin_amdgcn_mfma_f32_16x16x32_bf16(ah, bh, acc[n], 0, 0, 0);
            acc[n] = __builtin_amdgcn_mfma_f32_16x16x32_bf16(al, bh, acc[n], 0, 0, 0);
            acc[n] = __builtin_amdgcn_mfma_f32_16x16x32_bf16(ah, bl, acc[n], 0, 0, 0); }
    }
    __syncthreads();
    LAS float* lg = (LAS float*)(F.lds);
#pragma unroll
    for (int n = 0; n < 3; ++n) { const int col = 16 * n + li;
        if (col < 36) {
#pragma unroll
            for (int e = 0; e < 4; ++e) lg[(kh * 64 + mt * 16 + 4 * kq + e) * 37 + col] = acc[n][e]; } }
    __syncthreads();
    int e0 = 0, e1 = 0, s0 = 0, s1 = 0; float w0 = 0.f, w1 = 0.f;
    if (F.tid < 64) {
        const LAS float* l0 = lg + F.tid * 37; const LAS float* l1 = lg + (64 + F.tid) * 37;
        float gl[4];
#pragma unroll
        for (int o = 0; o < 4; ++o) gl[o] = (l0[o] + l1[o]) + lbias[o];
        int gi = 0; float gm = gl[0];
#pragma unroll
        for (int o = 1; o < 4; ++o) if (gl[o] > gm) { gm = gl[o]; gi = o; }
        float gden = 0.f;
#pragma unroll
        for (int o = 0; o < 4; ++o) gden += __expf(gl[o] - gm);
        const float g_w = 1.f / gden;
        float el[8];
#pragma unroll
        for (int o = 0; o < 8; ++o) el[o] = (l0[4 + gi * 8 + o] + l1[4 + gi * 8 + o]) + lbias[4 + gi * 8 + o];
        int i0 = 0; float v0 = el[0];
#pragma unroll
        for (int o = 1; o < 8; ++o) if (el[o] > v0) { v0 = el[o]; i0 = o; }
        int i1 = -1; float v1 = -INFINITY;
#pragma unroll
        for (int o = 0; o < 8; ++o) if (o != i0 && el[o] > v1) { v1 = el[o]; i1 = o; }
        w0 = g_w / (1.f + __expf(v1 - v0)); w1 = g_w - w0;
        e0 = gi * 8 + i0; e1 = gi * 8 + i1;
        s0 = __hip_atomic_fetch_add(lcnt + e0, 1, __ATOMIC_RELAXED, __HIP_MEMORY_SCOPE_WORKGROUP); s1 = __hip_atomic_fetch_add(lcnt + e1, 1, __ATOMIC_RELAXED, __HIP_MEMORY_SCOPE_WORKGROUP);
    }
    __syncthreads();
    if (F.tid < 32) { const int c = lcnt[F.tid]; lcnt[32 + F.tid] = c ? (int)__hip_atomic_fetch_add(gcnt + F.tid * 64, (unsigned)c, RLX_AGENT) : 0; }
    __syncthreads();
    if (F.tid < 64) { const int r = rowblk * 64 + F.tid; s0 += lcnt[32 + e0]; s1 += lcnt[32 + e1];
        rowtok[e0 * ROWCAP + s0] = r * 2; roww[e0 * ROWCAP + s0] = w0;
        rowtok[e1 * ROWCAP + s1] = r * 2 + 1; roww[e1 * ROWCAP + s1] = w1; }
    __syncthreads();
}

__device__ __forceinline__ void combine_phase(Frame& F, const bf16* og, const float* lse, bf16* ob) {
    const int gw = F.vcu * 8 + F.wave, NGW = F.G * 8;
    for (int row = gw; row < T; row += NGW) {
        const int h = F.lane >> 3;
        float l[3], w[3];
#pragma unroll
        for (int g = 0; g < 3; ++g) l[g] = lse[((size_t)g * T + row) * 8 + h];
        const float mx = fmaxf(l[0], fmaxf(l[1], l[2]));
        float den = 0.f;
#pragma unroll
        for (int g = 0; g < 3; ++g) { w[g] = __builtin_amdgcn_exp2f(l[g] - mx); den += w[g]; }
        const float inv = 1.f / den;
        float acc[8];
#pragma unroll
        for (int i = 0; i < 8; ++i) acc[i] = 0.f;
#pragma unroll
        for (int g = 0; g < 3; ++g) { const v4u o = *(const GAS v4u*)(og + ((size_t)g * T + row) * 512 + 8 * F.lane); const float wg_ = w[g] * inv;
            acc[0] += wg_ * bf_lo(o.x); acc[1] += wg_ * bf_hi(o.x); acc[2] += wg_ * bf_lo(o.y); acc[3] += wg_ * bf_hi(o.y);
            acc[4] += wg_ * bf_lo(o.z); acc[5] += wg_ * bf_hi(o.z); acc[6] += wg_ * bf_lo(o.w); acc[7] += wg_ * bf_hi(o.w); }
        v4u r; r.x = cvt_pk_bf16(acc[0], acc[1]); r.y = cvt_pk_bf16(acc[2], acc[3]); r.z = cvt_pk_bf16(acc[4], acc[5]); r.w = cvt_pk_bf16(acc[6], acc[7]);
        *(GAS v4u*)(ob + (size_t)row * 512 + 8 * F.lane) = r;
    }
}

__device__ __forceinline__ void final_phase(Frame& F, const bf16* x, const bf16* yb, const float* ygate, float* xo) {
    const int gw = F.vcu * 8 + F.wave, NGW = F.G * 8;
    for (int row = gw; row < T; row += NGW) {
#pragma unroll
        for (int j = 0; j < 4; ++j) { const v2u xb = *(const GAS v2u*)(x + (size_t)row * D + 4 * F.lane + 256 * j); f32x4 v = {bf_lo(xb.x), bf_hi(xb.x), bf_lo(xb.y), bf_hi(xb.y)};
            const v2u y0 = *(const GAS v2u*)(yb + (size_t)row * 2048 + 4 * F.lane + 256 * j), y1 = *(const GAS v2u*)(yb + (size_t)row * 2048 + 1024 + 4 * F.lane + 256 * j);
            const f32x4 gf = *(const GAS f32x4*)(ygate + (row >> 12) * 6144 + 4 * F.lane + 256 * j);
            v.x += gf.x * (bf_lo(y0.x) + bf_lo(y1.x)); v.y += gf.y * (bf_hi(y0.x) + bf_hi(y1.x)); v.z += gf.z * (bf_lo(y0.y) + bf_lo(y1.y)); v.w += gf.w * (bf_hi(y0.y) + bf_hi(y1.y));
            *(GAS f32x4*)(xo + (size_t)row * D + 4 * F.lane + 256 * j) = v; }
    }
}

struct EpiHN {
    static constexpr bool PERM = true;
    bf16* out0; size_t sec_stride; const float* gain0; long gdelta; int nnorm; float scale0; int tiles_per_sec, ld, gshift, dilated;
    __device__ __forceinline__ void operator()(const f32x4 (&acc)[2][2][4][2], const pg8::Unit& u, int, int wr, int wc, int fr, int fq) const {
        const int sec = u.pn / tiles_per_sec, pnl = u.pn - sec * tiles_per_sec;
        bf16* out = out0 + (size_t)sec * sec_stride;
        const bool nrm = sec < nnorm;
        const float scl = sec == 0 ? scale0 : 1.f;
        const int col0 = 256 * pnl + 64 * wc;
        f32x4 gv[2][2];
#pragma unroll
        for (int bj = 0; bj < 2; ++bj)
#pragma unroll
            for (int n = 0; n < 2; ++n) gv[bj][n] = nrm ? *(const f32x4*)(gain0 + (long)sec * gdelta + (col0 >> gshift) * 64 + 8 * fq + 32 * bj + 4 * n) * scl : (f32x4){1.f, 1.f, 1.f, 1.f};
#pragma unroll
        for (int ai = 0; ai < 2; ++ai)
#pragma unroll
            for (int m = 0; m < 4; ++m) {
                const int row = u.pm * 256 + ai * 128 + wr * 64 + m * 16 + fr;
                float rinv = 1.f;
                if (nrm) { float ss = 0.f;
#pragma unroll
                    for (int bj = 0; bj < 2; ++bj)
#pragma unroll
                        for (int n = 0; n < 2; ++n) { const f32x4 a = acc[ai][bj][m][n]; ss += (a.x * a.x + a.y * a.y) + (a.z * a.z + a.w * a.w); }
                    rinv = __builtin_amdgcn_rsqf(quad16_sum(ss) * (1.f / 64.f) + EPS); }
                bf16* orow;
                if (dilated) { const int g = col0 >> 9, hh = (col0 >> 6) & 7, sh = 2 * g, bb = row >> 12, s = row & 4095;
                    orow = out + ((size_t)(((g * 8 + hh) * 4 + bb) * 4096 + (s & ((1 << sh) - 1)) * (4096 >> sh) + (s >> sh))) * 64 + 8 * fq; }
                else orow = out + (size_t)row * ld + col0 + 8 * fq;
#pragma unroll
                for (int bj = 0; bj < 2; ++bj) { const f32x4 v0 = acc[ai][bj][m][0] * (gv[bj][0] * rinv), v1 = acc[ai][bj][m][1] * (gv[bj][1] * rinv);
                    v4u w; w.x = cvt_pk_bf16(v0.x, v0.y); w.y = cvt_pk_bf16(v0.z, v0.w); w.z = cvt_pk_bf16(v1.x, v1.y); w.w = cvt_pk_bf16(v1.z, v1.w);
                    *(v4u*)(orow + 32 * bj) = w; }
            }
    }
};
template <bool XF32> struct EpiResid {
    static constexpr bool PERM = true;
    const void* xin_; bf16* xout; const float* gate; gu32* cnt;
    __device__ __forceinline__ void operator()(const f32x4 (&acc)[2][2][4][2], const pg8::Unit& u, int, int wr, int wc, int fr, int fq) const {
        const int b = (u.pm * 256) >> 12, c0 = 256 * u.pn + 32 * wc + 8 * fq;
        const __amdgpu_buffer_rsrc_t rs = __builtin_amdgcn_make_buffer_rsrc(xout, 0, 32 << 20, 0x00020000);
        f32x4 gg[2][2];
#pragma unroll
        for (int bj = 0; bj < 2; ++bj)
#pragma unroll
            for (int n = 0; n < 2; ++n) gg[bj][n] = *(const f32x4*)(gate + b * 6144 + c0 + 128 * bj + 4 * n);
#pragma unroll
        for (int ai = 0; ai < 2; ++ai) {
            f32x4 xo[4][2][2];
#pragma unroll
            for (int m = 0; m < 4; ++m) { const size_t ro = (size_t)(u.pm * 256 + ai * 128 + wr * 64 + m * 16 + fr) * D + c0;
#pragma unroll
                for (int bj = 0; bj < 2; ++bj) {
                    if (XF32) { xo[m][bj][0] = *(const f32x4*)((const float*)xin_ + ro + 128 * bj); xo[m][bj][1] = *(const f32x4*)((const float*)xin_ + ro + 128 * bj + 4); }
                    else { const v4u xb = *(const v4u*)((const bf16*)xin_ + ro + 128 * bj);
                        xo[m][bj][0] = (f32x4){bf_lo(xb.x), bf_hi(xb.x), bf_lo(xb.y), bf_hi(xb.y)}; xo[m][bj][1] = (f32x4){bf_lo(xb.z), bf_hi(xb.z), bf_lo(xb.w), bf_hi(xb.w)}; } } }
#pragma unroll
            for (int m = 0; m < 4; ++m) { const size_t ro = (size_t)(u.pm * 256 + ai * 128 + wr * 64 + m * 16 + fr) * D + c0;
#pragma unroll
                for (int bj = 0; bj < 2; ++bj) { const f32x4 r0 = xo[m][bj][0] + gg[bj][0] * acc[ai][bj][m][0], r1 = xo[m][bj][1] + gg[bj][1] * acc[ai][bj][m][1];
                    v4u w; w.x = cvt_pk_bf16(r0.x, r0.y); w.y = cvt_pk_bf16(r0.z, r0.w); w.z = cvt_pk_bf16(r1.x, r1.y); w.w = cvt_pk_bf16(r1.z, r1.w);
                    __builtin_amdgcn_raw_buffer_store_b128(w, rs, (unsigned)(ro + 128 * bj) * 2u, 0, 16); } }
        }
        asm volatile("s_waitcnt vmcnt(0)" ::: "memory");
        if (fr == 0 && fq == 0) __hip_atomic_fetch_add(cnt + u.pm * 16, 1u, RLX_AGENT);
    }
};
struct EpiMoeGU {
    static constexpr bool PERM = true;
    bf16* act; gu32* cnt;
    __device__ __forceinline__ void operator()(const f32x4 (&acc)[2][2][4][2], const pg8::Unit& u, int, int wr, int wc, int fr, int fq) const {
        const int pnl = u.pn & 3;
        const __amdgpu_buffer_rsrc_t rs = __builtin_amdgcn_make_buffer_rsrc(act, 0, 44 << 20, 0x00020000);
#pragma unroll
        for (int ai = 0; ai < 2; ++ai) { if (ai == 1 && u.h) break;
#pragma unroll
            for (int m = 0; m < 4; ++m) {
                const int row = u.pm * 256 + ai * 128 + wr * 64 + m * 16 + fr;
                float r[8];
#pragma unroll
                for (int n = 0; n < 2; ++n)
#pragma unroll
                    for (int e = 0; e < 4; ++e) { const float g = acc[ai][0][m][n][e], up = acc[ai][1][m][n][e]; r[4 * n + e] = g * __builtin_amdgcn_rcpf(1.f + __expf(-g)) * up; }
                v4u w; w.x = cvt_pk_bf16(r[0], r[1]); w.y = cvt_pk_bf16(r[2], r[3]); w.z = cvt_pk_bf16(r[4], r[5]); w.w = cvt_pk_bf16(r[6], r[7]);
                __builtin_amdgcn_raw_buffer_store_b128(w, rs, (unsigned)(row * 512 + 128 * pnl + 32 * wc + 8 * fq) * 2u, 0, 16);
            } }
        asm volatile("s_waitcnt vmcnt(0)" ::: "memory");
        if (fr == 0 && fq == 0) __hip_atomic_fetch_add(cnt + u.pm * 16, 1u, RLX_AGENT);
    }
};
struct EpiMoeDown {
    static constexpr bool PERM = true;
    bf16* yb; const LAS int* tokl; const LAS float* wl;
    __device__ __forceinline__ void operator()(const f32x4 (&acc)[2][2][4][2], const pg8::Unit& u, int ui, int wr, int wc, int fr, int fq) const {
        const int pnl = u.pn & 3;
#pragma unroll
        for (int ai = 0; ai < 2; ++ai)
#pragma unroll
            for (int m = 0; m < 4; ++m) {
                const int r = ai * 128 + wr * 64 + m * 16 + fr;
                const int tk = tokl[(ui & 3) * 256 + r]; const float w = wl[(ui & 3) * 256 + r];
                if (tk >= 0) {
#pragma unroll
                    for (int bj = 0; bj < 2; ++bj) { const int c = 256 * pnl + 128 * bj + 32 * wc + 8 * fq;
                        const f32x4 v0 = acc[ai][bj][m][0] * w, v1 = acc[ai][bj][m][1] * w;
                        v4u o; o.x = cvt_pk_bf16(v0.x, v0.y); o.y = cvt_pk_bf16(v0.z, v0.w); o.z = cvt_pk_bf16(v1.x, v1.y); o.w = cvt_pk_bf16(v1.z, v1.w);
                        *(v4u*)(yb + (size_t)tk * 1024 + c) = o; }
                }
            }
    }
};

struct MoeOrder {
    const LAS int* ul; const LAS int* tokl; int K2; gu32* cnt; gu32* tmo;
    __device__ __forceinline__ bool next(int i, pg8::Unit& u) const {
        if (i >= 4) return false;
        const LAS int* d = ul + i * 8; if (!d[0]) return false;
        u.pm = d[1]; u.pn = d[2]; u.e = d[3]; u.rt = d[4]; u.h = d[5]; return true;
    }
    __device__ __forceinline__ unsigned goff(int ui, int row) const { const int tk = tokl[(ui & 3) * 256 + row]; return (unsigned)((tk < 0 ? 0 : (tk >> 1)) * K2); }
};
struct MoeOrderG : MoeOrder { static constexpr bool GATHER = true, MOE = true, A_SC1 = false; __device__ __forceinline__ void wait_ready(const pg8::Unit&) const {} };
struct MoeOrderC : MoeOrder { static constexpr bool GATHER = false, MOE = true, A_SC1 = true;
    __device__ __forceinline__ void wait_ready(const pg8::Unit& u) const {
        gu32* c = cnt + u.pm * 16; unsigned sp = 0;
        while (__hip_atomic_load(c, RLX_AGENT) < 32u) { __builtin_amdgcn_s_sleep(2);
            if ((++sp & 63u) == 0u) { if (__hip_atomic_load(tmo, RLX_AGENT) != 0u) break; if (sp > (1u << 17)) { __hip_atomic_store(tmo, 0xACDu, RLX_AGENT); break; } } }
    }
};

__device__ __forceinline__ void moe_decode(const LAS int* mt, int L, int nfull, int nhalf, LAS int* d) {
    int valid = 0, pm = 0, pn = 0, ue = 0, rt = 0, hh = 0;
    if (L >= 0 && L < 4 * (nfull + nhalf)) {
        valid = 1; const int tI = L >> 2, pnl = L & 3; int acc_t = 0, pstart = 0; bool found = false;
        if (tI < nfull) {
            for (int e = 0; e < 32 && !found; ++e) { const int c = mt[64 + e], tl = (c + 255) >> 8, lastrows = c - 256 * (tl - 1), hf = (tl > 0 && lastrows <= 128) ? 1 : 0, nf = tl - hf;
                if (tI < acc_t + nf) { ue = e; rt = tI - acc_t; pm = pstart + rt; hh = 0; found = true; } acc_t += nf; pstart += tl; }
        } else {
            const int th = tI - nfull;
            for (int e = 0; e < 32 && !found; ++e) { const int c = mt[64 + e], tl = (c + 255) >> 8, lastrows = c - 256 * (tl - 1), hf = (tl > 0 && lastrows <= 128) ? 1 : 0;
                if (hf && th == acc_t) { ue = e; rt = tl - 1; pm = pstart + rt; hh = 1; found = true; } acc_t += hf; pstart += tl; }
        }
        pn = ue * 4 + pnl;
    }
    d[0] = valid; d[1] = pm; d[2] = pn; d[3] = ue; d[4] = rt; d[5] = hh;
}

__device__ __forceinline__ void moe_tables(Frame& F, const gu32* gcnt, const int* rowtok, const float* roww) {
    LAS int* mt = (LAS int*)(F.lds + MT_OFF);
    LAS int* ul = (LAS int*)(F.lds + ULIST_OFF);
    LAS int* tokl = (LAS int*)(F.lds + TOKL_OFF); LAS int* tokl2 = (LAS int*)(F.lds + TOKL2_OFF); LAS float* wl = (LAS float*)(F.lds + WL_OFF);
    if (F.tid < 32) mt[64 + F.tid] = (int)__hip_atomic_load(gcnt + F.tid * 64, RLX_AGENT);
    __syncthreads();
    if (F.tid < 8) {
        int nfull = 0, nhalf = 0;
        for (int e = 0; e < 32; ++e) { const int c = mt[64 + e], tl = (c + 255) >> 8, lastrows = c - 256 * (tl - 1), hf = (tl > 0 && lastrows <= 128) ? 1 : 0; nfull += tl - hf; nhalf += hf; }
        const int U = 4 * (nfull + nhalf), G = F.G, c = F.vcu, i = F.tid & 3;
        int L;
        if (F.tid < 4) L = i * G + c;
        else {
            int extra = U - 2 * G; extra = extra < 0 ? 0 : (extra > G / 2 ? G / 2 : extra); const int NL = G - extra;
            if (c >= extra) L = i == 0 ? c - extra : (i == 1 ? NL + c : NL + G + (c - extra) + (i - 2) * NL);
            else L = i == 0 ? NL + c : -1;
        }
        moe_decode(mt, L, nfull, nhalf, ul + F.tid * 8);
    }
    __syncthreads();
    if (F.tid < 256) {
#pragma unroll
        for (int ui = 0; ui < 8; ++ui) { const LAS int* d = ul + ui * 8;
            if (d[0]) { const int e = d[3], idx = d[4] * 256 + F.tid; const bool ok = idx < mt[64 + e];
                const int tk = ok ? rowtok[e * ROWCAP + idx] : -1;
                if (ui < 4) tokl[ui * 256 + F.tid] = tk; else { tokl2[(ui - 4) * 256 + F.tid] = tk; wl[(ui - 4) * 256 + F.tid] = ok ? roww[e * ROWCAP + idx] : 0.f; } } }
    }
    __syncthreads();
}

namespace att {
__device__ __forceinline__ s16x4 vtr(const LAS char* p) { return __builtin_bit_cast(s16x4, __builtin_amdgcn_ds_read_tr16_b64_v4i16((LAS s16x4*)p)); }
__device__ __forceinline__ bf16x8 pack8(const f32x16& p, int s) {
    v4u w; w.x = cvtpk_s(p[8 * s + 0], p[8 * s + 1]); w.y = cvtpk_s(p[8 * s + 2], p[8 * s + 3]); w.z = cvtpk_s(p[8 * s + 4], p[8 * s + 5]); w.w = cvtpk_s(p[8 * s + 6], p[8 * s + 7]);
    return __builtin_bit_cast(bf16x8, w);
}
__device__ __forceinline__ float max16(const f32x16& p) {
    float a = fmaxf(fmaxf(p[0], p[1]), fmaxf(p[2], p[3])), b = fmaxf(fmaxf(p[4], p[5]), fmaxf(p[6], p[7]));
    float c = fmaxf(fmaxf(p[8], p[9]), fmaxf(p[10], p[11])), d = fmaxf(fmaxf(p[12], p[13]), fmaxf(p[14], p[15]));
    return fmaxf(fmaxf(a, b), fmaxf(c, d));
}
#define OFFR(r) (((r) & 3) + 8 * ((r) >> 2))

constexpr int A_KSTR = 272, A_VSTR = 320, A_STAGE = 64 * A_KSTR + 64 * A_VSTR, A_BT_OFF = 2 * A_STAGE, A_BT_N = 4224;
static_assert(A_BT_OFF + (A_BT_N + 128) * 4 <= RING_BYTES, "attnA LDS");

__device__ __forceinline__ float xhalf_max(float v) {
    float a = v, b = v; asm volatile("s_nop 1\n\tv_permlane32_swap_b32_e32 %0, %1\n\ts_nop 1" : "+v"(a), "+v"(b));     return fmaxf(a, b);
}
__device__ __forceinline__ float xhalf_sum(float v) { float a = v, b = v; asm volatile("s_nop 1\n\tv_permlane32_swap_b32_e32 %0, %1\n\ts_nop 1" : "+v"(a), "+v"(b));     return a + b; }
#define SBAR0() __builtin_amdgcn_sched_barrier(0)
constexpr float A_THR = 24.f;

__device__ __forceinline__ void a_bias(const LAS float* bt, f32x16& p0, f32x16& p1) {
#pragma unroll
    for (int r = 0; r < 16; ++r) { p0[r] = bt[OFFR(r)]; p1[r] = bt[OFFR(r) + 32]; }
}
__device__ __forceinline__ void a_qk(const LAS char* ka, const bf16x8 (&qf)[4], f32x16& p0, f32x16& p1) {
    bf16x8 kf[2][2];
    kf[0][0] = *(const LAS bf16x8*)(ka); kf[0][1] = *(const LAS bf16x8*)(ka + 32 * A_KSTR);
    SBAR0();
#pragma unroll
    for (int s = 0; s < 4; ++s) {
        if (s < 3) { kf[(s + 1) & 1][0] = *(const LAS bf16x8*)(ka + (s + 1) * 32); kf[(s + 1) & 1][1] = *(const LAS bf16x8*)(ka + 32 * A_KSTR + (s + 1) * 32); }
        SBAR0();
        p0 = __builtin_amdgcn_mfma_f32_32x32x16_bf16(kf[s & 1][0], qf[s], p0, 0, 0, 0); p1 = __builtin_amdgcn_mfma_f32_32x32x16_bf16(kf[s & 1][1], qf[s], p1, 0, 0, 0);
        SBAR0();
    }
}
#define A_PIN(x) asm volatile("" : "+v"(x))
template <int I> __device__ __forceinline__ void a_dma_piece(const char* gb, LAS char* lds, size_t kg, size_t vg, int kb, int vb, int w, const unsigned (&dgo)[5]) {
    const size_t so = I < 2 ? kg : (I == 2 ? (w == 0 ? kg : vg) : vg);
    const int dp = I == 0 ? kb + w * 1024 : I == 1 ? kb + (w + 8) * 1024 : I == 2 ? (w == 0 ? kb + 16 * 1024 : vb + (w - 1) * 1024) : I == 3 ? vb + (w + 7) * 1024 : (w < 5 ? vb + (w + 15) * 1024 : vb + (w + 7) * 1024);
    __builtin_amdgcn_global_load_lds((const unsigned*)(gb + so + dgo[I]), (LAS unsigned*)(lds + dp), 16, 0, 0);
}
__device__ __forceinline__ void a_fused(const LAS char* ka, const bf16x8 (&qf)[4], f32x16& n0, f32x16& n1, f32x16& c0, f32x16& c1, const LAS char* va, const LAS float* bt2, float& lsum, f32x16 (&o)[4],
                                        const char* gb, LAS char* lds, size_t kg, size_t vg, int kb, int vb, int w, const unsigned (&dgo)[5]) {
    bf16x8 kf[2][2]; v4u pw[4]; s16x4 lo[3], hh[3];
#define A_KRD(s_) do { kf[(s_) & 1][0] = *(const LAS bf16x8*)(ka + (s_) * 32); kf[(s_) & 1][1] = *(const LAS bf16x8*)(ka + 32 * A_KSTR + (s_) * 32); } while (0)
#define A_VRD(j_) do { lo[(j_) % 3] = vtr(va + ((j_) >> 2) * 16 * A_VSTR + ((j_) & 3) * 64); hh[(j_) % 3] = vtr(va + ((j_) >> 2) * 16 * A_VSTR + 8 * A_VSTR + ((j_) & 3) * 64); } while (0)
#define A_SOFT(C, m_) do { const float e0 = __builtin_amdgcn_exp2f(C[(2 * (m_)) & 15]), e1 = __builtin_amdgcn_exp2f(C[(2 * (m_) + 1) & 15]); \
        sA += e0; sB += e1; pw[(m_) >> 2][(m_) & 3] = cvtpk_s(e0, e1); A_PIN(pw[(m_) >> 2]); A_PIN(sA); A_PIN(sB); } while (0)
    A_KRD(0);
    float sA = 0.f, sB = 0.f;
    SBAR0();
#pragma unroll
    for (int i = 0; i < 8; ++i) {
        const int st = i >> 1;
        if (!(i & 1) && i < 6) A_KRD(st + 1);
        if (i >= 6) A_VRD(i - 6);
        if (i == 0) a_dma_piece<0>(gb, lds, kg, vg, kb, vb, w, dgo); if (i == 1) a_dma_piece<1>(gb, lds, kg, vg, kb, vb, w, dgo); if (i == 2) a_dma_piece<2>(gb, lds, kg, vg, kb, vb, w, dgo); if (i == 3) a_dma_piece<3>(gb, lds, kg, vg, kb, vb, w, dgo); if (i == 4) a_dma_piece<4>(gb, lds, kg, vg, kb, vb, w, dgo);
        SBAR0();
        if (i & 1) n1 = __builtin_amdgcn_mfma_f32_32x32x16_bf16(kf[st & 1][1], qf[st], n1, 0, 0, 0); else n0 = __builtin_amdgcn_mfma_f32_32x32x16_bf16(kf[st & 1][0], qf[st], n0, 0, 0, 0);
        A_SOFT(c0, i);
        SBAR0();
    }
#pragma unroll
    for (int j = 0; j < 16; ++j) {
        if (j + 2 < 16) A_VRD(j + 2);
        if (j >= 8) {
#pragma unroll
            for (int q = 0; q < 2; ++q) { const int r = 2 * (j - 8) + q; c0[r] = bt2[OFFR(r)]; c1[r] = bt2[OFFR(r) + 32]; } }
        SBAR0();
        { const s16x4 a = lo[j % 3], bq_ = hh[j % 3]; const bf16x8 vf = {a[0], a[1], a[2], a[3], bq_[0], bq_[1], bq_[2], bq_[3]};
          o[j & 3] = __builtin_amdgcn_mfma_f32_32x32x16_bf16(vf, __builtin_bit_cast(bf16x8, pw[j >> 2]), o[j & 3], 0, 0, 0); }
        if (j < 8) A_SOFT(c1, 8 + j);
        SBAR0();
    }
    lsum += sA + sB;
#undef A_KRD
#undef A_VRD
#undef A_SOFT
}

constexpr int A_KB = 64 * A_KSTR, A_VB = 64 * A_VSTR, A_VOFF = 2 * A_KB;
static_assert(A_VOFF + 2 * A_VB == A_BT_OFF, "attnA LDS map");
template <int MODE> __device__ __forceinline__ void attnA_unit(LAS char* lds, int b, int h, int qblk, const bf16* Q, const bf16* K, const bf16* V, bf16* O, const float* bt_g, const float* ut_g, float shift, float lam, const float* subln, float oscale) {
    const int tid = tid_fresh(), w = __builtin_amdgcn_readfirstlane(tid >> 6), l = tid & 63, r32 = l & 31, hi = l >> 5;
    const int qt = w & 3, c = w >> 2;
    LAS float* btab = (LAS float*)(lds + A_BT_OFF);
    { const f32x4 t0 = *(const f32x4*)(bt_g + 4 * tid), t1 = *(const f32x4*)(bt_g + 4 * (tid + 512));
      f32x4 t2 = {0.f, 0.f, 0.f, 0.f}; if (tid < 32) t2 = *(const f32x4*)(bt_g + 4 * (tid + 1024));
      *(LAS f32x4*)(btab + 4 * tid) = t0 - shift; *(LAS f32x4*)(btab + 4 * (tid + 512)) = t1 - shift; if (tid < 32) *(LAS f32x4*)(btab + 4 * (tid + 1024)) = t2 - shift; }
    const int q0w = qblk * 128 + qt * 32;
    const int qpos = q0w + r32;
    const size_t rowq = (size_t)b * SEQ + qpos;
    bf16x8 qf[4];
#pragma unroll
    for (int s = 0; s < 4; ++s) qf[s] = *(const bf16x8*)(Q + rowq * 1024 + h * 128 + c * 64 + 16 * s + 8 * hi);
    f32x16 o[4];
#pragma unroll
    for (int dt = 0; dt < 4; ++dt)
#pragma unroll
        for (int r = 0; r < 16; ++r) o[dt][r] = 0.f;
    float lsum = 0.f;
    const int nkt = 2 * (qblk + 1);
    const int my_last = (q0w + 31) >> 6;
    const bf16* Kg = K + (size_t)b * SEQ * 1024 + h * 128; const bf16* Vg = V + (size_t)b * SEQ * 1024 + h * 128;
    const size_t vdelta = (size_t)((const char*)Vg - (const char*)Kg);
    const int row0 = tid >> 4, cc = tid & 15;
    unsigned dgo[5]; (void)row0; (void)cc;
#pragma unroll
    for (int i = 0; i < 5; ++i) { const int j = w + 8 * i; int row, col;
        if (j < 17) { const int P = 64 * j + l; row = P / 17; col = P - 17 * row; } else { const int P = 64 * (j - 17) + l; row = P / 20; col = P - 20 * row; }
        col = col > 15 ? 15 : col; row = row > 63 ? 63 : row;
        dgo[i] = (unsigned)(row * 1024 + col * 8) * 2u; }
    if (w >= 5) dgo[4] = dgo[3];
#define A_DMA(i, gsrc, ldst) __builtin_amdgcn_global_load_lds((const unsigned*)((const char*)(gsrc) + dgo[i]), (LAS unsigned*)(ldst), 16, 0, 0)
#define A_DMAK(kt, buf) do { const bf16* kp_ = Kg + (size_t)(kt) * 65536; LAS char* kb_ = lds + (buf) * A_KB; \
        A_DMA(0, kp_, kb_ + w * 1024); A_DMA(1, kp_, kb_ + (w + 8) * 1024); if (w == 0) A_DMA(2, kp_, kb_ + 16 * 1024); } while (0)
#define A_DMAV(kt, buf) do { const bf16* vp_ = Vg + (size_t)(kt) * 65536; LAS char* vb_ = lds + A_VOFF + (buf) * A_VB; \
        if (w != 0) A_DMA(2, vp_, vb_ + (w - 1) * 1024); A_DMA(3, vp_, vb_ + (w + 7) * 1024); if (w < 5) A_DMA(4, vp_, vb_ + (w + 15) * 1024); } while (0)
#define A_DMAWAIT() asm volatile("s_waitcnt vmcnt(0)" ::: "memory")
    A_DMAK(0, 0); A_DMAV(0, 0); A_DMAK(1, 1);
    A_DMAWAIT();
    __syncthreads();
    const int q_ = (l & 15) >> 2, p_ = l & 3, rhalf = (l >> 4) & 1;
    const int ka_off = r32 * A_KSTR + c * 128 + hi * 16;
    const int va_off = A_VOFF + (4 * hi + q_) * A_VSTR + (16 * rhalf + 4 * p_) * 2;
    f32x16 sa0, sa1, sb0, sb1;
    const LAS float* bt0 = btab + (4095 - qpos + 4 * hi);
    a_bias(bt0, sa0, sa1); a_bias(bt0 + 64, sb0, sb1);
    a_qk(lds + ka_off, qf, sa0, sa1);
    __syncthreads();
#define A_STEP(t, c0, c1, n0, n1) do { \
        const int tk_ = (t) + 2 < nkt ? (t) + 2 : nkt - 1, tv_ = (t) + 1 < nkt ? (t) + 1 : nkt - 1; \
        const size_t kg_ = (size_t)tk_ * 131072, vg_ = vdelta + (size_t)tv_ * 131072; const int kb_ = ((t) & 1) * A_KB, vb_ = A_VOFF + (((t) + 1) & 1) * A_VB; \
        if ((t) <= my_last)     \
            a_fused(lds + (((t) + 1) & 1) * A_KB + ka_off, qf, n0, n1, c0, c1, lds + ((t) & 1) * A_VB + va_off, bt0 + 64 * ((t) + 2), lsum, o, (const char*)Kg, lds, kg_, vg_, kb_, vb_, w, dgo); \
        A_DMAWAIT(); \
        __syncthreads(); } while (0)
    for (int kt = 0; kt < nkt; kt += 2) { A_STEP(kt, sa0, sa1, sb0, sb1); A_STEP(kt + 1, sb0, sb1, sa0, sa1); }
#undef A_STEP
#undef A_DMA
#undef A_DMAK
#undef A_DMAV
#undef A_DMAWAIT
    const float lt = xhalf_sum(lsum), inv = 1.f / lt;
    LAS float* xch = (LAS float*)lds;
    if (c == 1) {
#pragma unroll
        for (int dt = 0; dt < 4; ++dt)
#pragma unroll
            for (int r = 0; r < 16; ++r) xch[(qt * 64 + dt * 16 + r) * 64 + l] = o[dt][r] * inv;
    }
    __syncthreads();
    if (c == 0) {
        float ss = 0.f;
#pragma unroll
        for (int dt = 0; dt < 4; ++dt)
#pragma unroll
            for (int r = 0; r < 16; ++r) { const float v = o[dt][r] * inv - lam * xch[(qt * 64 + dt * 16 + r) * 64 + l]; o[dt][r] = v; ss += v * v; }
        ss = xhalf_sum(ss);
        const float rn = __builtin_amdgcn_rsqf(ss * (1.f / 128.f) + EPS) * oscale;
        LAS char* st = lds + 65536 + (qt * 32 + r32) * 272;
#pragma unroll
        for (int dt = 0; dt < 4; ++dt)
#pragma unroll
            for (int g4 = 0; g4 < 4; ++g4) { const int d0 = 32 * dt + 8 * g4 + 4 * hi; const f32x4 sg = *(const f32x4*)(subln + d0);
                v2u wv; wv.x = cvt_pk_bf16(o[dt][4 * g4 + 0] * rn * sg.x, o[dt][4 * g4 + 1] * rn * sg.y); wv.y = cvt_pk_bf16(o[dt][4 * g4 + 2] * rn * sg.z, o[dt][4 * g4 + 3] * rn * sg.w);
                *(LAS v2u*)(st + d0 * 2) = wv; }
    }
    __syncthreads();
#pragma unroll
    for (int k = 0; k < 4; ++k) { const int rr = (tid >> 4) + 32 * k, cq = tid & 15;
        const v4u v = *(const LAS v4u*)(lds + 65536 + rr * 272 + cq * 16);
        *(v4u*)(O + ((size_t)b * SEQ + qblk * 128 + rr) * 1024 + h * 128 + cq * 8) = v; }
    __syncthreads();
}

constexpr int B_KSTR = 144, B_VSTR = 192, B_ROWS = 384, B_V_OFF = B_ROWS * B_KSTR, B_BT_OFF = B_V_OFF + B_ROWS * B_VSTR, B_BT_N = 224;
static_assert(B_BT_OFF + B_BT_N * 4 <= RING_BYTES, "attnB LDS");

template <bool HALF_T>
__device__ __forceinline__ void b_qk(const LAS char* ka, const bf16x8 (&qf)[4], f32x16& p0, f32x16& p1) {
    bf16x8 kf[2][2];
#pragma unroll
    for (int r = 0; r < 16; ++r) { p0[r] = 0.f; p1[r] = 0.f; }
    kf[0][0] = *(const LAS bf16x8*)(ka); if (!HALF_T) kf[0][1] = *(const LAS bf16x8*)(ka + 32 * B_KSTR);
    SBAR0();
#pragma unroll
    for (int s = 0; s < 4; ++s) {
        if (s < 3) { kf[(s + 1) & 1][0] = *(const LAS bf16x8*)(ka + (s + 1) * 32); if (!HALF_T) kf[(s + 1) & 1][1] = *(const LAS bf16x8*)(ka + 32 * B_KSTR + (s + 1) * 32); }
        SBAR0();
        p0 = __builtin_amdgcn_mfma_f32_32x32x16_bf16(kf[s & 1][0], qf[s], p0, 0, 0, 0); if (!HALF_T) p1 = __builtin_amdgcn_mfma_f32_32x32x16_bf16(kf[s & 1][1], qf[s], p1, 0, 0, 0);
        SBAR0();
    }
}
template <bool HALF_T>
__device__ __forceinline__ void b_softmax_pv(f32x16& p0, f32x16& p1, const LAS char* va, const LAS float* bt, int kbase_sp, int hi, float shift, float& lsum, f32x16 (&o)[2]) {
    { float bv[16];
#pragma unroll
      for (int r = 0; r < 16; ++r) bv[r] = bt[OFFR(r)];
      SBAR0();
#pragma unroll
      for (int r = 0; r < 16; ++r) p0[r] += bv[r] - shift;
      if (!HALF_T) { SBAR0();
#pragma unroll
          for (int r = 0; r < 16; ++r) bv[r] = bt[OFFR(r) + 32];
          SBAR0();
#pragma unroll
          for (int r = 0; r < 16; ++r) p1[r] += bv[r] - shift; } }
    if (kbase_sp < 0) {
#pragma unroll
        for (int r = 0; r < 16; ++r) { if (kbase_sp + 4 * hi + OFFR(r) < 0) p0[r] = -INFINITY; if (!HALF_T) { if (kbase_sp + 4 * hi + OFFR(r) + 32 < 0) p1[r] = -INFINITY; } }
    }
    float ps = 0.f;
#pragma unroll
    for (int r = 0; r < 16; ++r) { p0[r] = __builtin_amdgcn_exp2f(p0[r]); ps += p0[r]; if (!HALF_T) { p1[r] = __builtin_amdgcn_exp2f(p1[r]); ps += p1[r]; } }
    lsum += ps;
    bf16x8 pb[4]; pb[0] = pack8(p0, 0); pb[1] = pack8(p0, 1); if (!HALF_T) { pb[2] = pack8(p1, 0); pb[3] = pack8(p1, 1); }
    constexpr int NG = HALF_T ? 2 : 4;
    s16x4 lo[2][2], hh[2][2];
#pragma unroll
    for (int dt = 0; dt < 2; ++dt) { lo[0][dt] = vtr(va + dt * 64); hh[0][dt] = vtr(va + 8 * B_VSTR + dt * 64); }
    SBAR0();
#pragma unroll
    for (int s = 0; s < NG; ++s) {
        if (s < NG - 1) {
#pragma unroll
            for (int dt = 0; dt < 2; ++dt) { lo[(s + 1) & 1][dt] = vtr(va + (s + 1) * 16 * B_VSTR + dt * 64); hh[(s + 1) & 1][dt] = vtr(va + (s + 1) * 16 * B_VSTR + 8 * B_VSTR + dt * 64); }
        }
        SBAR0();
#pragma unroll
        for (int dt = 0; dt < 2; ++dt) { const s16x4 a = lo[s & 1][dt], bq = hh[s & 1][dt]; const bf16x8 vf = {a[0], a[1], a[2], a[3], bq[0], bq[1], bq[2], bq[3]};
            o[dt] = __builtin_amdgcn_mfma_f32_32x32x16_bf16(vf, pb[s], o[dt], 0, 0, 0); }
        SBAR0();
    }
}

struct BUnit { int g, dil, b, res, h, nn; };
__device__ __forceinline__ BUnit b_decode(int u) {
    BUnit x; x.g = u >> 9; const int idx = u & 511; x.dil = x.g == 0 ? 1 : (x.g == 1 ? 4 : 16); const int nper = 16 / x.dil;
    x.nn = idx % nper; const int rest = idx / nper; x.h = rest & 7; const int bp = rest >> 3; x.b = bp / x.dil; x.res = bp - x.b * x.dil; return x;
}
__device__ __forceinline__ size_t b_hbase(const BUnit& x) { return ((size_t)(((x.g * 8 + x.h) * 4 + x.b) * 4096 + x.res * (4096 / x.dil))) * 64; }

__device__ __forceinline__ void attnB_phase(LAS char* lds, int vcu, int G, const bf16* QB, const bf16* KS, const bf16* VS, bf16* OG, float* LSE, const float* biasb, const float* shifts) {
    const int tid = tid_fresh(), w = __builtin_amdgcn_readfirstlane(tid >> 6), l = tid & 63, r32 = l & 31, hi = l >> 5;
    const int q_ = (l & 15) >> 2, p_ = l & 3, rhalf = (l >> 4) & 1;
    LAS float* btab = (LAS float*)(lds + B_BT_OFF);
    v4u kv[6], vv[6]; bf16x8 qn[4]; float btv = 0.f;
#define B_PREFETCH(X) do { const size_t hb_ = b_hbase(X); \
        _Pragma("unroll") for (int it = 0; it < 6; ++it) { const int ch = tid + 512 * it, i = ch >> 3, c8 = ch & 7, sp = 256 * (X).nn - 128 + i, spc = sp < 0 ? 0 : sp; \
            const size_t go = hb_ + (size_t)spc * 64 + c8 * 8; kv[it] = *(const v4u*)(KS + go); vv[it] = *(const v4u*)(VS + go); } \
        _Pragma("unroll") for (int s = 0; s < 4; ++s) qn[s] = *(const bf16x8*)(QB + hb_ + (size_t)(256 * (X).nn + 32 * w + r32) * 64 + 16 * s + 8 * hi); \
        if (tid < B_BT_N) btv = biasb[((X).g * 8 + (X).h) * 224 + tid]; } while (0)
    int u = vcu;
    if (u >= 1536) return;
    BUnit cur = b_decode(u);
    B_PREFETCH(cur);
#pragma unroll 1
    for (;;) {
#pragma unroll
        for (int it = 0; it < 6; ++it) { const int ch = tid + 512 * it, i = ch >> 3, c8 = ch & 7, sp = 256 * cur.nn - 128 + i;
            const v4u z = {0u, 0u, 0u, 0u};
            *(LAS v4u*)(lds + i * B_KSTR + c8 * 16) = sp < 0 ? z : kv[it]; *(LAS v4u*)(lds + B_V_OFF + i * B_VSTR + c8 * 16) = sp < 0 ? z : vv[it]; }
        if (tid < B_BT_N) btab[tid] = btv;
        bf16x8 qf[4];
#pragma unroll
        for (int s = 0; s < 4; ++s) qf[s] = qn[s];
        __syncthreads();
        const int un = u + G; const bool has_next = un < 1536;
        BUnit nxt = cur; if (has_next) { nxt = b_decode(un); B_PREFETCH(nxt); }
        const float shift = shifts[cur.g];
        f32x16 o[2];
#pragma unroll
        for (int dt = 0; dt < 2; ++dt)
#pragma unroll
            for (int r = 0; r < 16; ++r) o[dt][r] = 0.f;
        float lsum = 0.f;
        const int i00 = 32 * w, kb0 = 256 * cur.nn - 128 + i00;
        const bool v0 = kb0 + 63 >= 0, v1 = kb0 + 127 >= 0;
        const LAS char* ka = lds + (i00 + r32) * B_KSTR + hi * 16;
        const LAS char* va = lds + B_V_OFF + (i00 + 4 * hi + q_) * B_VSTR + (16 * rhalf + 4 * p_) * 2;
        const LAS float* bt = btab + (31 - r32 + 4 * hi);
        f32x16 s00, s01, s10, s11, s20, s21;
        if (v0) b_qk<false>(ka, qf, s00, s01);
        if (v1) b_qk<false>(ka + 64 * B_KSTR, qf, s10, s11);
        b_qk<true>(ka + 128 * B_KSTR, qf, s20, s21);
        SBAR0();
        if (v0) b_softmax_pv<false>(s00, s01, va, bt, kb0, hi, shift, lsum, o);
        if (v1) b_softmax_pv<false>(s10, s11, va + 64 * B_VSTR, bt + 64, kb0 + 64, hi, shift, lsum, o);
        b_softmax_pv<true>(s20, s21, va + 128 * B_VSTR, bt + 128, kb0 + 128, hi, shift, lsum, o);
        const float lt = xhalf_sum(lsum), inv = 1.f / lt;
        bf16* OGg = OG + (size_t)cur.g * T * 512; float* LSEg = LSE + (size_t)cur.g * T * 8;
        const size_t tq = (size_t)cur.b * SEQ + (size_t)(256 * cur.nn + 32 * w + r32) * cur.dil + cur.res;
        if (hi == 0) LSEg[tq * 8 + cur.h] = shift + __builtin_amdgcn_logf(lt);
        __syncthreads();
        LAS char* st = lds + w * 4608;
#pragma unroll
        for (int dt = 0; dt < 2; ++dt)
#pragma unroll
            for (int g4 = 0; g4 < 4; ++g4) { const int d0 = 32 * dt + 8 * g4 + 4 * hi;
                v2u wv; wv.x = cvt_pk_bf16(o[dt][4 * g4 + 0] * inv, o[dt][4 * g4 + 1] * inv); wv.y = cvt_pk_bf16(o[dt][4 * g4 + 2] * inv, o[dt][4 * g4 + 3] * inv);
                *(LAS v2u*)(st + r32 * 144 + d0 * 2) = wv; }
#pragma unroll
        for (int k = 0; k < 4; ++k) { const int rr = (l >> 3) + 8 * k, cq = l & 7;
            const v4u v = *(const LAS v4u*)(st + rr * 144 + cq * 16);
            const size_t tr = (size_t)cur.b * SEQ + (size_t)(256 * cur.nn + 32 * w + rr) * cur.dil + cur.res;
            *(v4u*)(OGg + tr * 512 + cur.h * 64 + cq * 8) = v; }
        __syncthreads();
        if (!has_next) break;
        cur = nxt; u = un;
    }
#undef B_PREFETCH
}
}

struct Args { Inputs in; float* out; unsigned char* ws; int ph_lo, ph_hi, probe, pad; };
constexpr int N_PHASES = 32;
#ifndef SITE_MASK
#define SITE_MASK 0xFFFFFFFFu
#endif
#define SITE(id) (((SITE_MASK) >> (id)) & 1u)

typedef const Args __attribute__((address_space(4))) CArgs;
__device__ __forceinline__ CArgs* kargs() { CArgs* p = (CArgs*)__builtin_amdgcn_kernarg_segment_ptr(); asm volatile("" : "+s"(p)); return p; }

__global__ void __launch_bounds__(512, 2) fwd_kernel(Args args) {
    extern __shared__ __attribute__((aligned(16))) unsigned char lds_raw[];
    Frame F;
    F.lds = (LAS unsigned char*)lds_raw;
    F.tid = threadIdx.x; F.lane = F.tid & 63; F.wave = __builtin_amdgcn_readfirstlane(F.tid >> 6);
    F.G = gridDim.x; { const int bx = blockIdx.x; F.vcu = (F.G % 8 == 0) ? (bx % 8) * (F.G / 8) + bx / 8 : bx; }
    F.ws = args.ws;
    for (int u = F.tid; u < 64; u += 512) ((LAS unsigned*)(F.lds + LDSCTL_OFF))[u] = 0u;
    __syncthreads();
    const int lo = args.ph_lo, hi = args.ph_hi;
    const bool one_launch = (hi - lo) > 1;
    XcdBarrier bar; bar.bar = (unsigned*)(args.ws + WS_CTL) + CW_BAR; bar.x = 0; bar.st = nullptr;
    if (one_launch) bar = xcd_barrier_post((unsigned*)(args.ws + WS_CTL) + CW_BAR, (volatile LAS unsigned*)(F.lds + MISC_OFF) + 8);
#define IN(k) (lo <= (k) && (k) < hi)
#define SEAM(k) do { if (IN(k) && IN((k) + 1)) xcd_barrier(bar); } while (0)
#define ENTER() CArgs* ap = kargs(); const Inputs __attribute__((address_space(4)))& I = ap->in; F.ws = ap->ws; F.tid = tid_fresh(); F.lane = F.tid & 63; F.wave = __builtin_amdgcn_readfirstlane(F.tid >> 6); \
    bf16* X = (bf16*)(F.ws + WS_X); float* OUT = ap->out; (void)OUT; const float* MOD = (const float*)(F.ws + WS_MOD); bf16* HN = (bf16*)(F.ws + WS_HN); bf16* YB = (bf16*)(F.ws + WS_YB); bf16* ACT = (bf16*)(F.ws + WS_ACT); \
    int* ROWTOK = (int*)(F.ws + WS_ROWTOK); float* ROWW = (float*)(F.ws + WS_ROWW); gu32* CTL = (gu32*)(F.ws + WS_CTL); const bool PR = ap->probe != 0; bf16* Xo = PR ? (bf16*)(F.ws + WS_PROBE) : X; bf16* HNo = PR ? (bf16*)(F.ws + WS_PROBE + 64 * MiB) : HN; (void)Xo; (void)HNo; (void)X; (void)MOD; (void)HN; (void)YB; (void)ACT; (void)ROWTOK; (void)ROWW; (void)CTL; (void)I

    if (SITE(0) && IN(0)) { ENTER(); p0_prologue(F, I); } SEAM(0);

#pragma unroll 1
    for (int L = 0; L < 2; ++L) {
        const int pb = 1 + 7 * L;
#define mod (MOD + L * 4 * 6144)
        if (SITE(1) && IN(pb + 0)) { ENTER();
            if (L == 0) norm_phase<true>(F, I.p[0], nullptr, nullptr, nullptr, I.p[5], mod, mod + 1024, 6144, HNo, nullptr, nullptr, nullptr, 0, nullptr);
            else norm_phase<false>(F, X, Xo, YB, MOD + (L - 1) * 4 * 6144 + 5120, I.p[5] + L * D, mod, mod + 1024, 6144, HNo, nullptr, nullptr, nullptr, 0, nullptr);
        } SEAM(pb + 0);
        if (SITE(2) && IN(pb + 1)) { ENTER();
            pg8::Gemm g{HN, (const bf16*)(F.ws + WS_WQKVA) + (size_t)L * 3072 * 1024, T, 3072, D}; pg8::StaticOrder S; S.init(T, 3072, F.G, (int)blockIdx.x);
            EpiHN E{(bf16*)(F.ws + WS_QA), (WS_KA - WS_QA) / 2, I.p[8] + L * 64, (long)(I.p[9] - I.p[8]), 2, QSCALE, 4, 1024, 30, 0};
            pg8::gemm_phase<EpiHN, pg8::StaticOrder>(F.lds, g, S, E);
        } SEAM(pb + 1);
        if (SITE(3) && IN(pb + 2)) { ENTER();
            const float lam = ((const float*)(F.ws + WS_LAM))[L], shiftA = ((const float*)(F.ws + WS_LAM))[2 + L];
            const float lam_init = L == 0 ? 0.2f : 0.35550906759096906f;
#pragma unroll 1
            for (int pi2 = 2 * F.vcu; pi2 < 1024; pi2 += (pi2 & 1) ? 2 * F.G - 1 : 1) { const int pi = pi2 >> 1, bh = pi >> 4, j = pi & 15, b = bh >> 3, h = bh & 7;
#if MK_N_LAUNCHES == 0 && defined(PROBE_ATT_MODE)
                if (PR) att::attnA_unit<PROBE_ATT_MODE>((LAS char*)F.lds, b, h, (pi2 & 1) ? 31 - j : j, (const bf16*)(F.ws + WS_QA), (const bf16*)(F.ws + WS_KA), (const bf16*)(F.ws + WS_VA), (bf16*)(F.ws + WS_PROBE), (const float*)(F.ws + WS_BIASA) + h * 4224, (const float*)(F.ws + WS_UTAB) + h * 128, shiftA, lam, I.p[11] + L * 128, 1.f - lam_init); else
#endif
                att::attnA_unit<0>((LAS char*)F.lds, b, h, (pi2 & 1) ? 31 - j : j, (const bf16*)(F.ws + WS_QA), (const bf16*)(F.ws + WS_KA), (const bf16*)(F.ws + WS_VA), (bf16*)(F.ws + WS_OA), (const float*)(F.ws + WS_BIASA) + h * 4224, (const float*)(F.ws + WS_UTAB) + h * 128, shiftA, lam, I.p[11] + L * 128, 1.f - lam_init); }
        } SEAM(pb + 2);
        if (SITE(4) && IN(pb + 3)) { ENTER();
            pg8::Gemm g{(const bf16*)(F.ws + WS_OA), (const bf16*)(F.ws + WS_WOA) + (size_t)L * 1024 * 1024, T, D, D}; pg8::StaticOrder S; S.init(T, D, F.G, (int)blockIdx.x);
            gu32* xc = CTL + CW_XP + (PR ? 4 + L : L) * 1024;
            if (L == 0) { EpiResid<true> E{I.p[0], Xo, mod + 2048, xc}; pg8::gemm_phase<EpiResid<true>, pg8::StaticOrder>(F.lds, g, S, E); }
            else { EpiResid<false> E{X, Xo, mod + 2048, xc}; pg8::gemm_phase<EpiResid<false>, pg8::StaticOrder>(F.lds, g, S, E); }
        }
        if (SITE(5) && IN(pb + 4)) { ENTER();
            const int rowblk = F.vcu;
            router_phase(F, X, rowblk, ((ap->ph_hi - ap->ph_lo) > 1 && !PR) ? CTL + CW_XP + L * 1024 : nullptr, CTL + CW_TMO, I.p[6] + L * D, mod + 3072, mod + 4096, HNo, (const float*)(F.ws + WS_RWT) + (size_t)L * 36 * 1024, I.p[22] + L * 4, I.p[24] + L * 32, CTL + CW_GCNT + 2048 * (PR ? 4 + L : L), PR ? (int*)(F.ws + WS_PROBE + 96 * MiB) : ROWTOK, PR ? (float*)(F.ws + WS_PROBE + 100 * MiB) : ROWW);
        } SEAM(pb + 4);
        if (SITE(6) && IN(pb + 5)) { ENTER();
            moe_tables(F, CTL + CW_GCNT + 2048 * L, ROWTOK, ROWW);
            pg8::Gemm g{HN, (const bf16*)(F.ws + WS_MGU) + (size_t)L * 32 * 1024 * 1024, 0, 1024, D};
            MoeOrderG S; S.ul = (const LAS int*)(F.lds + ULIST_OFF); S.tokl = (const LAS int*)(F.lds + TOKL_OFF); S.K2 = 2048; S.cnt = nullptr; S.tmo = nullptr;
            EpiMoeGU E{ACT, CTL + CW_ACT + (PR ? 4 + L : L) * 2560};
            pg8::gemm_phase<EpiMoeGU, MoeOrderG>(F.lds, g, S, E);
        }
        if (SITE(7) && IN(pb + 6)) { ENTER();
            if (!one_launch) moe_tables(F, CTL + CW_GCNT + 2048 * L, ROWTOK, ROWW);
            pg8::Gemm g{ACT, (const bf16*)(F.ws + WS_MDN) + (size_t)L * 32 * 1024 * 512, 0, 1024, 512};
            MoeOrderC S; S.ul = (const LAS int*)(F.lds + ULIST_OFF) + 32; S.tokl = (const LAS int*)(F.lds + TOKL2_OFF); S.K2 = 1024; S.cnt = CTL + CW_ACT + L * 2560; S.tmo = CTL + CW_TMO;
            EpiMoeDown E{YB, (const LAS int*)(F.lds + TOKL2_OFF), (const LAS float*)(F.lds + WL_OFF)};
            pg8::gemm_phase<EpiMoeDown, MoeOrderC>(F.lds, g, S, E);
        } SEAM(pb + 6);
    }

#pragma unroll 1
    for (int J = 0; J < 2; ++J) {
        const int L = 2 + J, pb = 15 + 8 * J;
#define kvmod ((const float*)(F.ws + WS_KVMOD))
        if (SITE(8) && IN(pb + 0)) { ENTER();
            if (J == 0) norm_phase<false>(F, X, Xo, YB, MOD + (L - 1) * 4 * 6144 + 5120, I.p[5] + L * D, mod, mod + 1024, 6144, HNo, I.p[13], kvmod, kvmod + 1024, 2048, PR ? (bf16*)(F.ws + WS_PROBE + 104 * MiB) : (bf16*)(F.ws + WS_HKV));
            else norm_phase<false>(F, X, Xo, YB, MOD + (L - 1) * 4 * 6144 + 5120, I.p[5] + L * D, mod, mod + 1024, 6144, HNo, nullptr, nullptr, nullptr, 0, nullptr);
        } SEAM(pb + 0);
        if (SITE(9) && IN(pb + 1)) { ENTER();
            const int xcd_ = F.vcu >> 5, rk_ = F.vcu & 31, hr_ = J == 0 ? 16 : 8;
            const bool split = (F.G == 256) && !PR, helper = split && rk_ >= 32 - hr_;
            if (helper) {
                LAS float* scr64 = (LAS float*)(F.lds + F.wave * 16640);
                const int hw = ((xcd_ * hr_ + rk_ - (32 - hr_)) * 8 + F.wave), nhw = 64 * hr_;
                if (J == 0) { for (int it = hw; it < MOE_ITEMS64 + HELP_N3A; it += nhw) moe_item64(F.ws, I.p[25], I.p[26], I.p[27], it < MOE_ITEMS64 ? 2 : 3, it < MOE_ITEMS64 ? it : it - MOE_ITEMS64, scr64, F.lane); }
                else { for (int it = HELP_N3A + hw; it < MOE_ITEMS64; it += nhw) moe_item64(F.ws, I.p[25], I.p[26], I.p[27], 3, it, scr64, F.lane); }
                __syncthreads();
            } else
            { pg8::Gemm g{HN, (const bf16*)(F.ws + WS_WQB) + (size_t)J * 1536 * 1024, T, 1536, D}; pg8::StaticOrder S;
              if (split) S.init(T, 1536, 8 * (32 - hr_), rk_ * 8 + xcd_); else S.init(T, 1536, F.G, (int)blockIdx.x);
              EpiHN E{(bf16*)(F.ws + WS_QB), 0, I.p[19] + J * 192, 0, 1, QSCALE, 6, 1536, 9, 1};
              pg8::gemm_phase<EpiHN, pg8::StaticOrder>(F.lds, g, S, E); }
            if (SITE(10) && J == 0) { pg8::Gemm g{(const bf16*)(F.ws + WS_HKV), (const bf16*)(F.ws + WS_WKV), T, 3072, D}; pg8::StaticOrder S; S.init(T, 3072, F.G, (int)blockIdx.x);
              EpiHN E{(bf16*)(F.ws + WS_KS), (WS_VS - WS_KS) / 2, I.p[17], 0, 1, 1.f, 6, 1536, 9, 1};
              pg8::gemm_phase<EpiHN, pg8::StaticOrder>(F.lds, g, S, E); }
        } SEAM(pb + 1);
        if (SITE(11) && IN(pb + 2)) { ENTER();
            att::attnB_phase((LAS char*)F.lds, F.vcu, F.G, (const bf16*)(F.ws + WS_QB), (const bf16*)(F.ws + WS_KS), (const bf16*)(F.ws + WS_VS), (bf16*)(F.ws + WS_OG), (float*)(F.ws + WS_LSE),
                             (const float*)(F.ws + WS_BIASB), (const float*)(F.ws + WS_LAM) + 4 + J * 3);
        } SEAM(pb + 2);
        if (SITE(12) && IN(pb + 3)) { ENTER(); combine_phase(F, (const bf16*)(F.ws + WS_OG), (const float*)(F.ws + WS_LSE), (bf16*)(F.ws + WS_OB)); } SEAM(pb + 3);
        if (SITE(13) && IN(pb + 4)) { ENTER();
            pg8::Gemm g{(const bf16*)(F.ws + WS_OB), (const bf16*)(F.ws + WS_WOB) + (size_t)J * 1024 * 512, T, D, 512}; pg8::StaticOrder S; S.init(T, D, F.G, (int)blockIdx.x);
            EpiResid<false> E{X, Xo, mod + 2048, CTL + CW_XP + (PR ? 4 + L : L) * 1024};
            pg8::gemm_phase<EpiResid<false>, pg8::StaticOrder>(F.lds, g, S, E);
        }
        if (SITE(14) && IN(pb + 5)) { ENTER();
            const int rowblk = F.vcu;
            router_phase(F, X, rowblk, ((ap->ph_hi - ap->ph_lo) > 1 && !PR) ? CTL + CW_XP + L * 1024 : nullptr, CTL + CW_TMO, I.p[6] + L * D, mod + 3072, mod + 4096, HNo, (const float*)(F.ws + WS_RWT) + (size_t)L * 36 * 1024, I.p[22] + L * 4, I.p[24] + L * 32, CTL + CW_GCNT + 2048 * (PR ? 4 + L : L), PR ? (int*)(F.ws + WS_PROBE + 96 * MiB) : ROWTOK, PR ? (float*)(F.ws + WS_PROBE + 100 * MiB) : ROWW);
        } SEAM(pb + 5);
        if (SITE(15) && IN(pb + 6)) { ENTER();
            moe_tables(F, CTL + CW_GCNT + 2048 * L, ROWTOK, ROWW);
            pg8::Gemm g{HN, (const bf16*)(F.ws + WS_MGU) + (size_t)L * 32 * 1024 * 1024, 0, 1024, D};
            MoeOrderG S; S.ul = (const LAS int*)(F.lds + ULIST_OFF); S.tokl = (const LAS int*)(F.lds + TOKL_OFF); S.K2 = 2048; S.cnt = nullptr; S.tmo = nullptr;
            EpiMoeGU E{ACT, CTL + CW_ACT + (PR ? 4 + L : L) * 2560};
            pg8::gemm_phase<EpiMoeGU, MoeOrderG>(F.lds, g, S, E);
        }
        if (SITE(16) && IN(pb + 7)) { ENTER();
            if (!one_launch) moe_tables(F, CTL + CW_GCNT + 2048 * L, ROWTOK, ROWW);
            pg8::Gemm g{ACT, (const bf16*)(F.ws + WS_MDN) + (size_t)L * 32 * 1024 * 512, 0, 1024, 512};
            MoeOrderC S; S.ul = (const LAS int*)(F.lds + ULIST_OFF) + 32; S.tokl = (const LAS int*)(F.lds + TOKL2_OFF); S.K2 = 1024; S.cnt = CTL + CW_ACT + L * 2560; S.tmo = CTL + CW_TMO;
            EpiMoeDown E{YB, (const LAS int*)(F.lds + TOKL2_OFF), (const LAS float*)(F.lds + WL_OFF)};
            pg8::gemm_phase<EpiMoeDown, MoeOrderC>(F.lds, g, S, E);
        } SEAM(pb + 7);
    }
    if (SITE(17) && IN(31)) { ENTER(); final_phase(F, X, YB, MOD + 3 * 4 * 6144 + 5120, PR ? (float*)(F.ws + WS_PROBE) : OUT); }
#undef IN
#undef SEAM
}

extern "C" void kernel_launch(void* const* d_in, const int* in_sizes, int n_in, void* d_out, int out_size, void* d_ws, size_t ws_size, hipStream_t stream) {
    static int grid = 0;
    if (grid == 0) {
        if (n_in != 28 || out_size != T * D || ws_size < WS_END) { fprintf(stderr, "kernel_launch: unexpected problem (n_in %d, out %d, ws %zu); nothing launched\n", n_in, out_size, ws_size); grid = -1; return; }
        int dev = 0, cus = 0, per_cu = 0;
        if (hipGetDevice(&dev) != hipSuccess || hipDeviceGetAttribute(&cus, hipDeviceAttributeMultiprocessorCount, dev) != hipSuccess) { grid = -1; return; }
        if (hipFuncSetAttribute((const void*)fwd_kernel, hipFuncAttributeMaxDynamicSharedMemorySize, LDS_BYTES) != hipSuccess) { fprintf(stderr, "kernel_launch: hipFuncSetAttribute failed\n"); grid = -1; return; }
        if (hipOccupancyMaxActiveBlocksPerMultiprocessor(&per_cu, (const void*)fwd_kernel, 512, LDS_BYTES) != hipSuccess || per_cu < 1) { fprintf(stderr, "kernel_launch: occupancy query says %d\n", per_cu); (void)hipGetLastError(); grid = -1; return; }
        grid = cus < 256 ? cus : 256;
        if (grid != 256) { fprintf(stderr, "kernel_launch: built for a 256-CU device (one workgroup per CU; the worker / helper splits of the GEMM phases assume 8 XCDs x 32 workgroups)\n"); grid = -1; return; }
    }
    if (grid < 0) return;
    (void)hipMemsetAsync((char*)d_ws + WS_CTL, 0, CTL_ZERO_BYTES, stream);
    Args a{};
    for (int i = 0; i < 28; ++i) a.in.p[i] = (const float*)d_in[i];
    a.out = (float*)d_out; a.ws = (unsigned char*)d_ws;
#if MK_N_LAUNCHES == 1
    a.ph_lo = 0; a.ph_hi = N_PHASES;
    hipLaunchKernelGGL(fwd_kernel, dim3(grid), dim3(512), LDS_BYTES, stream, a);
#else
#ifndef PROBE_DUP_MASK
#define PROBE_DUP_MASK 0u
#endif
    for (int p = 0; p < N_PHASES; ++p) { a.ph_lo = p; a.ph_hi = p + 1;
        for (int rep = 0; rep < (((PROBE_DUP_MASK) >> p) & 1u ? 2 : 1); ++rep) { a.probe = rep; hipLaunchKernelGGL(fwd_kernel, dim3(grid), dim3(512), LDS_BYTES, stream, a); } }
#endif
}
```

```cpp
#include <hip/hip_runtime.h>
#include <cstdio>
#include <cstdint>

#ifndef MK_N_LAUNCHES
#define MK_N_LAUNCHES 1
#endif

#define GAS __attribute__((address_space(1)))
#define LAS __attribute__((address_space(3)))
typedef unsigned short bf16;
typedef unsigned v4u __attribute__((ext_vector_type(4)));
typedef unsigned v2u __attribute__((ext_vector_type(2)));
typedef float f32x4 __attribute__((ext_vector_type(4)));
typedef float f32x2 __attribute__((ext_vector_type(2)));
typedef float f32x16 __attribute__((ext_vector_type(16)));
typedef short bf16x8 __attribute__((ext_vector_type(8)));
typedef short s16x4 __attribute__((ext_vector_type(4)));
typedef GAS unsigned gu32;
#define RLX_AGENT __ATOMIC_RELAXED, __HIP_MEMORY_SCOPE_AGENT
#define LDS_WAIT() asm volatile("s_waitcnt lgkmcnt(0)" ::: "memory")
#define VM_WAIT() asm volatile("s_waitcnt vmcnt(0)" ::: "memory")

__device__ __forceinline__ unsigned cvt_pk_bf16(float lo, float hi) { unsigned r; asm volatile("v_cvt_pk_bf16_f32 %0, %1, %2" : "=v"(r) : "v"(lo), "v"(hi)); return r; }
typedef __bf16 bf16x2_t __attribute__((ext_vector_type(2)));
__device__ __forceinline__ unsigned cvtpk_s(float lo, float hi) { f32x2 v = {lo, hi}; bf16x2_t b = __builtin_convertvector(v, bf16x2_t); return __builtin_bit_cast(unsigned, b); }
__device__ __forceinline__ float bf_lo(unsigned u) { return __builtin_bit_cast(float, u << 16); }
__device__ __forceinline__ float bf_hi(unsigned u) { return __builtin_bit_cast(float, u & 0xffff0000u); }

constexpr int D = 1024, BATCH = 4, SEQ = 4096, T = BATCH * SEQ;
constexpr int NE = 32;
constexpr int ROWCAP = T;
constexpr float EPS = 1e-6f;
constexpr float LOG2E = 1.4426950408889634f;
constexpr float QSCALE = 0.125f * LOG2E;

namespace pg8 {
#define PG8_LAS __attribute__((address_space(3)))
typedef unsigned short bf16_t;
constexpr int BM = 256, BK = 64, HALF = 128, HTB = HALF * BK * 2  , STAGE_BYTES = 8 * HTB, NXCD = 8, WGM = 4;

__host__ __device__ __forceinline__ int lds_byte(int r, int c) { const int st = (r >> 4) * 2 + (c >> 5), rr = r & 15, cc = c & 31, ob = rr * 64 + cc * 2; return st * 1024 + (ob ^ (((ob >> 9) & 1) << 5)); }
__host__ __device__ __forceinline__ void stage_rc(int b, int& R, int& C) { const int st = b / 1024, sb = b % 1024, swz = sb ^ (((sb >> 9) & 1) << 5); R = (st >> 1) * 16 + swz / 64; C = (st & 1) * 32 + (swz % 64) / 2; }
__host__ __device__ __forceinline__ int perm32(int rho) { const int n = rho >> 4, i = rho & 15; return 8 * (i >> 2) + 4 * n + (i & 3); }

struct Unit { int pm, pn, e, rt, h; };
struct Gemm { const bf16_t* A; const bf16_t* Bt; int M, N, K; };

struct StaticOrder {
    static constexpr bool GATHER = false, MOE = false, A_SC1 = false;
    int nM, nN, nwg, G, c;
    __host__ __device__ __forceinline__ void init(int M, int N, int G_, int c_) { nM = M / BM; nN = N / BM; nwg = nM * nN; G = G_; c = c_; }
    __host__ __device__ __forceinline__ bool next(int i, Unit& u) const {
        const long L = (long)i * G + c; if (L >= nwg) return false;
        int wgid = (int)L; { const int q = nwg / NXCD, r = nwg % NXCD, xcd = wgid % NXCD, off = wgid / NXCD; wgid = (xcd < r ? xcd * (q + 1) : r * (q + 1) + (xcd - r) * q) + off; }
        const int nig = WGM * nN, gid = wgid / nig, fm = gid * WGM, gsz = (nM - fm) < WGM ? (nM - fm) : WGM;
        u.pm = fm + ((wgid % nig) % gsz); u.pn = (wgid % nig) / gsz; u.e = 0; u.rt = 0; u.h = 0; return true;
    }
    __device__ __forceinline__ unsigned goff(int, int) const { return 0u; }
    __device__ __forceinline__ void wait_ready(const Unit&) const {}
    __device__ __forceinline__ unsigned poll(const Unit&) const { return 0u; }
    __device__ __forceinline__ void wait_polled(const Unit&, unsigned) const {}
};
template <class Epi, class Sched>
__device__ __forceinline__ void gemm_phase(PG8_LAS unsigned char* lds, const Gemm g, const Sched& S, const Epi& E) {
    constexpr bool GATHER = Sched::GATHER; constexpr bool GATHER_OR_MOE = Sched::MOE;
    int tid_ = threadIdx.x; asm volatile("" : "+v"(tid_));
    const int tid = tid_, wid = __builtin_amdgcn_readfirstlane(tid >> 6), lane = tid & 63, wr = wid >> 2, wc = wid & 3, fr = lane & 15, fq = lane >> 4;
    const int K = g.K, nt = K / BK;
    unsigned voffA[2], voffB[2]; int RA[2], CA[2];
#pragma unroll
    for (int i = 0; i < 2; ++i) { int R, C; stage_rc(tid * 16 + i * 8192, R, C); const int Rb = Epi::PERM ? ((R & ~31) + perm32(R & 31)) : R;
        voffA[i] = (unsigned)(R * K + C) * 2u; voffB[i] = (unsigned)(Rb * K + C) * 2u; RA[i] = R; CA[i] = C; }
    const size_t kstep = (size_t)(BK * 2);
    const size_t hstep = (size_t)HALF * K * 2;
    const size_t hstepA = GATHER ? (size_t)0 : hstep;
    const size_t tstep = 2 * hstep;
    const unsigned ldsw = (unsigned)wid * 1024u;
    const int aoff = lds_byte(wr * 64 + fr, fq * 8), boff = lds_byte(wc * 32 + fr, fq * 8);
#define PG8_SA(b, h) (((b) * 2 + (h)) * HTB)
#define PG8_SB(b, h) ((4 + (b) * 2 + (h)) * HTB)
#define PG8_STAGE2X(bufoff, gbase, v0, v1, aux) do { \
        __builtin_amdgcn_global_load_lds((const unsigned*)((const char*)(gbase) + (v0)), (PG8_LAS unsigned*)(lds + (bufoff) + ldsw), 16, 0, aux); \
        __builtin_amdgcn_global_load_lds((const unsigned*)((const char*)(gbase) + (v1)), (PG8_LAS unsigned*)(lds + (bufoff) + ldsw + 8192), 16, 0, aux); } while (0)
#define PG8_STAGE2(bufoff, gbase, v0, v1) PG8_STAGE2X(bufoff, gbase, v0, v1, 0)
#define PG8_STAGE(bufoff, gbase, voff) PG8_STAGE2(bufoff, gbase, (voff)[0], (voff)[1])
#define PG8_STAGE_A(bufoff, gbase, g0, g1) do { if constexpr (GATHER) PG8_STAGE2(bufoff, gbase, g0, g1); else if constexpr (Sched::A_SC1) PG8_STAGE2X(bufoff, gbase, voffA[0], voffA[1], 16); else PG8_STAGE2(bufoff, gbase, voffA[0], voffA[1]); } while (0)
#define PG8_LDA(dst, b, h) do { _Pragma("unroll") for (int m = 0; m < 4; ++m) _Pragma("unroll") for (int k = 0; k < 2; ++k) dst[m][k] = *(const PG8_LAS bf16x8*)(lds + PG8_SA(b, h) + aoff + m * 2048 + k * 1024); } while (0)
#define PG8_LDB(dst, b, h) do { _Pragma("unroll") for (int n = 0; n < 2; ++n) _Pragma("unroll") for (int k = 0; k < 2; ++k) dst[n][k] = *(const PG8_LAS bf16x8*)(lds + PG8_SB(b, h) + boff + n * 2048 + k * 1024); } while (0)
#define PG8_MMA(ai, bj, At, Bt) do { __builtin_amdgcn_s_setprio(1); _Pragma("unroll") for (int m = 0; m < 4; ++m) _Pragma("unroll") for (int n = 0; n < 2; ++n) _Pragma("unroll") for (int k = 0; k < 2; ++k) \
        acc[ai][bj][m][n] = __builtin_amdgcn_mfma_f32_16x16x32_bf16(Bt[n][k], At[m][k], acc[ai][bj][m][n], 0, 0, 0); __builtin_amdgcn_s_setprio(0); } while (0)
#define PG8_WAIT_V(n) asm volatile("s_waitcnt vmcnt(" #n ")" ::: "memory")
#define PG8_WAIT_L(n) asm volatile("s_waitcnt lgkmcnt(" #n ")" ::: "memory")
#define PG8_BAR __builtin_amdgcn_s_barrier()
#define PG8_SCHED __builtin_amdgcn_sched_barrier(0)
    Unit cur, nxt; int ui = 0;
    if (!S.next(0, cur)) return;
    S.wait_ready(cur);
    f32x4 acc[2][2][4][2];
#pragma unroll
    for (int a = 0; a < 2; ++a)
#pragma unroll
        for (int b = 0; b < 2; ++b)
#pragma unroll
            for (int m = 0; m < 4; ++m)
#pragma unroll
                for (int n = 0; n < 2; ++n) acc[a][b][m][n] = (f32x4){0.f, 0.f, 0.f, 0.f};
    bf16x8 At[4][2], B0[2][2], B1[2][2];
    unsigned gc00 = 0u, gc01 = 0u, gc10 = 0u, gc11 = 0u, gn00 = 0u, gn01 = 0u, gn10 = 0u, gn11 = 0u;
    if constexpr (GATHER) {
        gc00 = S.goff(0, RA[0]) + (unsigned)CA[0] * 2u; gc01 = S.goff(0, RA[1]) + (unsigned)CA[1] * 2u;
        gc10 = S.goff(0, 128 + RA[0]) + (unsigned)CA[0] * 2u; gc11 = S.goff(0, 128 + RA[1]) + (unsigned)CA[1] * 2u;
    }
    const char* cA = GATHER ? (const char*)g.A : (const char*)g.A + (size_t)cur.pm * tstep; const char* cB = (const char*)g.Bt + (size_t)cur.pn * tstep;
    PG8_STAGE(PG8_SB(0, 0), cB, voffB); PG8_STAGE(PG8_SB(0, 1), cB + hstep, voffB); PG8_STAGE_A(PG8_SA(0, 0), cA, gc00, gc01); PG8_STAGE_A(PG8_SA(0, 1), cA + hstepA, gc10, gc11);
    if (wr == 1) PG8_BAR;
    PG8_WAIT_V(2); PG8_BAR;
    PG8_STAGE(PG8_SB(1, 0), cB + kstep, voffB); PG8_STAGE_A(PG8_SA(1, 0), cA + kstep, gc00, gc01); PG8_STAGE(PG8_SB(1, 1), cB + hstep + kstep, voffB);
    PG8_WAIT_V(6); PG8_BAR;
    for (;;) {
        const bool has_next = S.next(ui + 1, nxt);
        const unsigned polled = has_next ? S.poll(nxt) : 0u;
        const char* nA = GATHER ? (const char*)g.A : (has_next ? (const char*)g.A + (size_t)nxt.pm * tstep : cA); const char* nB = has_next ? (const char*)g.Bt + (size_t)nxt.pn * tstep : cB;
        if constexpr (GATHER) {
            if (has_next) { gn00 = S.goff(ui + 1, RA[0]) + (unsigned)CA[0] * 2u; gn01 = S.goff(ui + 1, RA[1]) + (unsigned)CA[1] * 2u;
                            gn10 = S.goff(ui + 1, 128 + RA[0]) + (unsigned)CA[0] * 2u; gn11 = S.goff(ui + 1, 128 + RA[1]) + (unsigned)CA[1] * 2u; }
            else { gn00 = gc00; gn01 = gc01; gn10 = gc10; gn11 = gc11; }
        }
        const bool halfu = GATHER_OR_MOE ? (cur.h != 0) : false;
        for (int t = 0; t < nt; t += 2) {
            const bool last = (t == nt - 2);
            if (last && has_next) S.wait_polled(nxt, polled);
            const char* a1 = cA + (size_t)(t + 1) * kstep;
            const char* a2 = last ? nA : cA + (size_t)(t + 2) * kstep; const char* b2 = last ? nB : cB + (size_t)(t + 2) * kstep;
            const char* a3 = a2 + kstep; const char* b3 = b2 + kstep;
            unsigned s00 = 0u, s01 = 0u, s10 = 0u, s11 = 0u;
            if constexpr (GATHER) { s00 = last ? gn00 : gc00; s01 = last ? gn01 : gc01; s10 = last ? gn10 : gc10; s11 = last ? gn11 : gc11; }
            PG8_LDB(B0, 0, 0); PG8_LDB(B1, 0, 1); PG8_SCHED; PG8_LDA(At, 0, 0); PG8_STAGE_A(PG8_SA(1, 1), a1 + hstepA, gc10, gc11);
            PG8_WAIT_V(8); PG8_WAIT_L(0); PG8_BAR; PG8_MMA(0, 0, At, B0); PG8_MMA(0, 1, At, B1); PG8_BAR; PG8_SCHED;
            if (!halfu) PG8_LDA(At, 0, 1); PG8_STAGE(PG8_SB(0, 0), b2, voffB); PG8_STAGE(PG8_SB(0, 1), b2 + hstep, voffB); PG8_STAGE_A(PG8_SA(0, 0), a2, s00, s01);
            PG8_WAIT_V(8); PG8_WAIT_L(0); PG8_BAR; if (!halfu) { PG8_MMA(1, 0, At, B0); PG8_MMA(1, 1, At, B1); } PG8_BAR; PG8_SCHED;
            PG8_LDB(B0, 1, 0); PG8_LDB(B1, 1, 1); PG8_SCHED; PG8_LDA(At, 1, 0); PG8_STAGE_A(PG8_SA(0, 1), a2 + hstepA, s10, s11);
            PG8_WAIT_V(8); PG8_WAIT_L(0); PG8_BAR; PG8_MMA(0, 0, At, B0); PG8_MMA(0, 1, At, B1); PG8_BAR; PG8_SCHED;
            if (!halfu) PG8_LDA(At, 1, 1); PG8_STAGE(PG8_SB(1, 0), b3, voffB); PG8_STAGE(PG8_SB(1, 1), b3 + hstep, voffB); PG8_STAGE_A(PG8_SA(1, 0), a3, s00, s01);
            PG8_WAIT_V(8); PG8_WAIT_L(0); PG8_BAR; if (!halfu) { PG8_MMA(1, 0, At, B0); PG8_MMA(1, 1, At, B1); } PG8_BAR; PG8_SCHED;
        }
        if (wr == 0) PG8_BAR;
        E(acc, cur, ui, wr, wc, fr, fq);
        if (!has_next) break;
#pragma unroll
        for (int a = 0; a < 2; ++a)
#pragma unroll
            for (int b = 0; b < 2; ++b)
#pragma unroll
                for (int m = 0; m < 4; ++m)
#pragma unroll
                    for (int n = 0; n < 2; ++n) acc[a][b][m][n] = (f32x4){0.f, 0.f, 0.f, 0.f};
        cur = nxt; cA = nA; cB = nB; ++ui;
        if constexpr (GATHER) { gc00 = gn00; gc01 = gn01; gc10 = gn10; gc11 = gn11; }
        if (wr == 1) PG8_BAR;
    }
    PG8_WAIT_V(0);
    PG8_BAR;
#undef PG8_SA
#undef PG8_SB
#undef PG8_STAGE
#undef PG8_STAGE2
#undef PG8_STAGE2X
#undef PG8_STAGE_A
#undef PG8_LDA
#undef PG8_LDB
#undef PG8_MMA
#undef PG8_WAIT_V
#undef PG8_WAIT_L
#undef PG8_BAR
#undef PG8_SCHED
}
}

#define XB_TMO      128
#define XB_XCNT(j)  (256  + 64 * (j))
#define XB_XSUB(j)  (1280 + 64 * (j))
#define XB_XGEN(j)  (2304 + 64 * (j))
#define XB_TOP      3328
#define XB_TOPGEN   3392
#define XCD_BAR_WORDS 3456
#define XB_SPIN_CAP (1u << 18)

__device__ __forceinline__ unsigned xb_ld(unsigned* p)              { return __hip_atomic_load(p, __ATOMIC_RELAXED, __HIP_MEMORY_SCOPE_AGENT); }
__device__ __forceinline__ unsigned xb_add(unsigned* p, unsigned v) { return __hip_atomic_fetch_add(p, v, __ATOMIC_RELAXED, __HIP_MEMORY_SCOPE_AGENT); }
__device__ __forceinline__ unsigned xb_xcc_id() { return (unsigned)__builtin_amdgcn_s_getreg((3 << 11) | 20) & 0xFu; }
#define XB_SPIN(cond, bar) do { unsigned _sp = 0; while (cond) { __builtin_amdgcn_s_sleep(1); \
    if ((++_sp & 255u) == 0u) { if (xb_ld(&(bar)[XB_TMO])) break; if (_sp > XB_SPIN_CAP) { atomicAdd(&(bar)[XB_TMO], 1u); break; } } } } while (0)

struct XcdBarrier {
    unsigned* bar; unsigned x;
    volatile LAS unsigned* st;
};

__device__ __forceinline__ XcdBarrier xcd_barrier_post(unsigned* bar, volatile LAS unsigned* st) {
    XcdBarrier b; b.bar = bar; b.x = xb_xcc_id(); b.st = st;
    if (threadIdx.x == 0) (void)xb_add(&bar[XB_XCNT(b.x)], 1u);
    return b;
}
__device__ __forceinline__ void xcd_barrier_complete(unsigned* bar, unsigned x, unsigned& nloc, unsigned& nx) {
    const unsigned G = gridDim.x * gridDim.y * gridDim.z;
    unsigned sum, cnt, mine, sp = 0u;
    for (;;) {
        sum = 0u; cnt = 0u; mine = 0u;
#pragma unroll
        for (unsigned j = 0; j < 16; ++j) { const unsigned c = xb_ld(&bar[XB_XCNT(j)]); sum += c; cnt += (c > 0u) ? 1u : 0u; mine = (j == x) ? c : mine; }
        if (sum == G) break;
        __builtin_amdgcn_s_sleep(1);
        if ((++sp & 255u) == 0u) { if (xb_ld(&bar[XB_TMO])) break; if (sp > XB_SPIN_CAP) { atomicAdd(&bar[XB_TMO], 1u); break; } }
    }
    nloc = mine > 0u ? mine : 1u; nx = cnt > 0u ? cnt : 1u;
}

__device__ __forceinline__ void xcd_barrier(const XcdBarrier& b) {
    asm volatile("s_waitcnt vmcnt(0)" ::: "memory");
    __syncthreads();
    if (threadIdx.x == 0) {
        unsigned* bar = b.bar;
        __builtin_amdgcn_s_waitcnt(0);
        unsigned nloc = b.st[0], nx = b.st[1];
        if (nloc == 0u) { xcd_barrier_complete(bar, b.x, nloc, nx); b.st[0] = nloc; b.st[1] = nx; }
        const unsigned old = xb_add(&bar[XB_XSUB(b.x)], 1u);
        const unsigned gen = old / nloc;
        if (old + 1u == (gen + 1u) * nloc) {
            __builtin_amdgcn_fence(__ATOMIC_RELEASE, "agent");
            asm volatile("s_waitcnt vmcnt(0)" ::: "memory");
            const unsigned og = xb_add(&bar[XB_TOP], 1u);
            const unsigned tg = og / nx;
            if (og + 1u != (tg + 1u) * nx) XB_SPIN(xb_ld(&bar[XB_TOP]) < (tg + 1u) * nx, bar);
            __builtin_amdgcn_fence(__ATOMIC_ACQUIRE, "agent");
            b.st[2] = tg + 1u;
            asm volatile("s_waitcnt vmcnt(0)" ::: "memory");
        } else {
            const unsigned ep = b.st[2]; b.st[2] = ep + 1u;
            XB_SPIN(xb_ld(&bar[XB_TOP]) < (ep + 1u) * nx, bar);
            __builtin_amdgcn_fence(__ATOMIC_ACQUIRE, "agent");
            asm volatile("s_waitcnt vmcnt(0)" ::: "memory");
        }
    }
    __syncthreads();
}

constexpr size_t MiB = 1u << 20;
constexpr size_t WS_CTL = 0, CTL_ZERO_BYTES = MiB / 4;
constexpr size_t WS_MOD = 1 * MiB;
constexpr size_t WS_KVMOD = WS_MOD + (size_t)4 * 4 * 6144 * 4;
constexpr size_t WS_BIASA = 2 * MiB;
constexpr size_t WS_BIASB = WS_BIASA + (size_t)8 * 4224 * 4;
constexpr size_t WS_LAM = WS_BIASB + (size_t)3 * 8 * 224 * 4;
constexpr size_t WS_UTAB = WS_LAM + 64;
constexpr size_t WS_RWT = 7 * MiB;
constexpr size_t WS_ROWTOK = 3 * MiB;
constexpr size_t WS_ROWW = 5 * MiB;
constexpr size_t WS_WQKVA = 8 * MiB;
constexpr size_t WS_WOA = 20 * MiB;
constexpr size_t WS_WKV = 24 * MiB;
constexpr size_t WS_WQB = 30 * MiB;
constexpr size_t WS_WOB = 36 * MiB;
constexpr size_t WS_MGU = 40 * MiB;
constexpr size_t WS_MDN = 296 * MiB;
constexpr size_t WS_HN = 424 * MiB;
constexpr size_t WS_HKV = 456 * MiB;
constexpr size_t WS_QA = 488 * MiB, WS_KA = 520 * MiB, WS_VA = 552 * MiB;
constexpr size_t WS_OA = 584 * MiB;
constexpr size_t WS_QB = 488 * MiB;
constexpr size_t WS_OG = 536 * MiB;
constexpr size_t WS_OB = 584 * MiB;
constexpr size_t WS_LSE = 600 * MiB;
constexpr size_t WS_KS = 616 * MiB, WS_VS = 664 * MiB;
constexpr size_t WS_ACT = 712 * MiB;
constexpr size_t WS_YB = 754 * MiB;
constexpr size_t WS_LLT = 1000 * MiB;
constexpr size_t WS_LLW = 1004 * MiB;
constexpr size_t WS_CNT = 1008 * MiB;
constexpr size_t WS_X = 940 * MiB;
constexpr size_t WS_PROBE = 820 * MiB;
constexpr size_t WS_END = 972 * MiB;

constexpr int CW_TMO = 0, CW_CODE = 1;
constexpr int CW_BAR = 4096;
constexpr int CW_GCNT = 8192;
constexpr int CW_XP = 24576;
constexpr int CW_ACT = 32768;
static_assert((CW_GCNT + 8 * 2048) <= CW_ACT && (CW_ACT + 8 * 160 * 16) * 4 <= (int)CTL_ZERO_BYTES, "ctl");

constexpr int RING_BYTES = 131072;
constexpr int SCR_BYTES = 147456;
constexpr int LDSCTL_OFF = SCR_BYTES, MISC_OFF = LDSCTL_OFF + 64;
constexpr int TOKL_OFF = LDSCTL_OFF + 256;
constexpr int WL_OFF = TOKL_OFF + 4096;
constexpr int MT_OFF = WL_OFF + 4096;
constexpr int ULIST_OFF = MT_OFF + 512;
constexpr int HIST_OFF = ULIST_OFF + 256;
constexpr int REC_OFF = HIST_OFF + 256;
constexpr int LDS_BYTES = 163840;
constexpr int TOKL2_OFF = REC_OFF;
static_assert(REC_OFF + 128 * 32 <= LDS_BYTES, "LDS map");

struct Frame {
    LAS unsigned char* lds;
    int tid, lane, wave, vcu, G;
    unsigned char* ws;
};
__device__ __forceinline__ int tid_fresh() { int t = threadIdx.x; asm volatile("" : "+v"(t)); return t; }

__device__ __forceinline__ float wave_sum(float v) {
    v += __builtin_bit_cast(float, __builtin_amdgcn_update_dpp(0, __builtin_bit_cast(int, v), 0xB1, 0xF, 0xF, true));
    v += __builtin_bit_cast(float, __builtin_amdgcn_update_dpp(0, __builtin_bit_cast(int, v), 0x4E, 0xF, 0xF, true));
    v += __builtin_bit_cast(float, __builtin_amdgcn_update_dpp(0, __builtin_bit_cast(int, v), 0x141, 0xF, 0xF, true));
    v += __builtin_bit_cast(float, __builtin_amdgcn_update_dpp(0, __builtin_bit_cast(int, v), 0x140, 0xF, 0xF, true));
    const int i = __builtin_bit_cast(int, v);
    const float s0 = __builtin_bit_cast(float, __builtin_amdgcn_readlane(i, 0)), s1 = __builtin_bit_cast(float, __builtin_amdgcn_readlane(i, 16));
    const float s2 = __builtin_bit_cast(float, __builtin_amdgcn_readlane(i, 32)), s3 = __builtin_bit_cast(float, __builtin_amdgcn_readlane(i, 48));
    return (s0 + s1) + (s2 + s3);
}

__device__ __forceinline__ float wave_max(float v) {
    v = fmaxf(v, __builtin_bit_cast(float, __builtin_amdgcn_update_dpp(__builtin_bit_cast(int, v), __builtin_bit_cast(int, v), 0xB1, 0xF, 0xF, false)));
    v = fmaxf(v, __builtin_bit_cast(float, __builtin_amdgcn_update_dpp(__builtin_bit_cast(int, v), __builtin_bit_cast(int, v), 0x4E, 0xF, 0xF, false)));
    v = fmaxf(v, __builtin_bit_cast(float, __builtin_amdgcn_update_dpp(__builtin_bit_cast(int, v), __builtin_bit_cast(int, v), 0x141, 0xF, 0xF, false)));
    v = fmaxf(v, __builtin_bit_cast(float, __builtin_amdgcn_update_dpp(__builtin_bit_cast(int, v), __builtin_bit_cast(int, v), 0x140, 0xF, 0xF, false)));
    const int i = __builtin_bit_cast(int, v);
    const float s0 = __builtin_bit_cast(float, __builtin_amdgcn_readlane(i, 0)), s1 = __builtin_bit_cast(float, __builtin_amdgcn_readlane(i, 16));
    const float s2 = __builtin_bit_cast(float, __builtin_amdgcn_readlane(i, 32)), s3 = __builtin_bit_cast(float, __builtin_amdgcn_readlane(i, 48));
    return fmaxf(fmaxf(s0, s1), fmaxf(s2, s3));
}

__device__ __forceinline__ float quad16_sum(float v) {
    float a = v, b = v; asm volatile("s_nop 1\n\tv_permlane16_swap_b32_e32 %0, %1\n\ts_nop 1" : "+v"(a), "+v"(b)); v = a + b;
    a = v; b = v; asm volatile("s_nop 1\n\tv_permlane32_swap_b32_e32 %0, %1\n\ts_nop 1" : "+v"(a), "+v"(b)); return a + b;
}

__device__ __forceinline__ int t5_bucket(int n) {
    if (n < 16) return n;
    return 16 + (n >= 22) + (n >= 30) + (n >= 40) + (n >= 54) + (n >= 73) + (n >= 99) + (n >= 134) + (n >= 182) + (n >= 246) + (n >= 332) + (n >= 450) + (n >= 609) + (n >= 825) + (n >= 1117) + (n >= 1513);
}

__device__ __forceinline__ void p0_transpose_item(const float* W, int K, int N, bf16* WT, int k0, int n0, int orow0, LAS float* scr, int lane) {
#pragma unroll 8
    for (int i = 0; i < 32; ++i) { const int kk = 2 * i + (lane >> 5); scr[kk * 33 + (lane & 31)] = W[(size_t)(k0 + kk) * N + n0 + (lane & 31)]; }
    LDS_WAIT(); asm volatile("" ::: "memory");
    const int c = lane & 7;
#pragma unroll
    for (int j = 0; j < 4; ++j) { const int n = (lane >> 3) + 8 * j; const LAS float* s = scr + (8 * c) * 33 + n;
        v4u o; o.x = cvt_pk_bf16(s[0 * 33], s[1 * 33]); o.y = cvt_pk_bf16(s[2 * 33], s[3 * 33]); o.z = cvt_pk_bf16(s[4 * 33], s[5 * 33]); o.w = cvt_pk_bf16(s[6 * 33], s[7 * 33]);
        *(GAS v4u*)(WT + (size_t)(orow0 + n) * K + k0 + 8 * c) = o; }
    LDS_WAIT(); asm volatile("" ::: "memory");
}
__device__ __forceinline__ void p0_transpose_item64(const float* W, int K, int N, bf16* WT, int k0, int n0, int orow0, LAS float* scr, int lane) {
    const int kk = lane >> 4, n4 = (lane & 15) * 4;
    f32x4 v[16];
#pragma unroll
    for (int i = 0; i < 16; ++i) v[i] = *(const GAS f32x4*)(W + (size_t)(k0 + 4 * i + kk) * N + n0 + n4);
#pragma unroll
    for (int i = 0; i < 16; ++i) { LAS float* d = scr + (4 * i + kk) * 65 + n4; d[0] = v[i].x; d[1] = v[i].y; d[2] = v[i].z; d[3] = v[i].w; }
    LDS_WAIT(); asm volatile("" ::: "memory");
    const int c = lane & 7;
#pragma unroll
    for (int j = 0; j < 8; ++j) { const int n = (lane >> 3) + 8 * j; const LAS float* s = scr + (8 * c) * 65 + n;
        v4u o; o.x = cvt_pk_bf16(s[0 * 65], s[1 * 65]); o.y = cvt_pk_bf16(s[2 * 65], s[3 * 65]); o.z = cvt_pk_bf16(s[4 * 65], s[5 * 65]); o.w = cvt_pk_bf16(s[6 * 65], s[7 * 65]);
        *(GAS v4u*)(WT + (size_t)(orow0 + n) * K + k0 + 8 * c) = o; }
    LDS_WAIT(); asm volatile("" ::: "memory");
}
constexpr int MOE_ITEMS64 = 32 * 384;
__device__ __forceinline__ void moe_item64(unsigned char* ws, const float* wgate, const float* wup, const float* wdown, int lyr, int it, LAS float* scr, int lane) {
    const int le = lyr * 32 + it / 384; int r = it % 384;
    if (r < 256) { const int up = r >> 7; r &= 127; const int kb = r / 8, nb = r % 8, n0 = nb * 64;
        p0_transpose_item64((up ? wup : wgate) + (size_t)le * 1024 * 512, 1024, 512, (bf16*)(ws + WS_MGU) + (size_t)le * 1024 * 1024, kb * 64, n0, 256 * (n0 >> 7) + 128 * up + (n0 & 127), scr, lane); }
    else { r -= 256; const int kb = r / 16, nb = r % 16, n0 = nb * 64;
        p0_transpose_item64(wdown + (size_t)le * 512 * 1024, 512, 1024, (bf16*)(ws + WS_MDN) + (size_t)le * 1024 * 512, kb * 64, n0, n0, scr, lane); }
}
constexpr int HELP_N3A = 6144;
__device__ __forceinline__ int headperm_row(int n) { const int L = n & 255; return (n & ~255) + 128 * ((L >> 5) & 1) + 32 * (L >> 6) + (L & 31); }

struct Inputs { const float* p[28]; };

template <class IT> __device__ __forceinline__ void p0_prologue(Frame& F, const IT& I) {
    LAS float* cact = (LAS float*)(F.lds);
    LAS float* red = (LAS float*)(F.lds + 16384);
    for (int i = F.tid; i < 4096; i += 512) { const float v = I.p[1][i]; cact[i] = v / (1.f + __expf(-v)); }
    __syncthreads();
    for (int it = F.vcu; it < 416; it += F.G) {
        const float* W; const float* bias; float* out; int N, nb;
        if (it < 384) { const int layer = it / 96; nb = it % 96; N = 6144; W = I.p[3] + (size_t)layer * 1024 * 6144; bias = I.p[4] + layer * 6144; out = (float*)(F.ws + WS_MOD) + layer * 4 * 6144; }
        else { nb = it - 384; N = 2048; W = I.p[14]; bias = I.p[15]; out = (float*)(F.ws + WS_KVMOD); }
        const int n = nb * 64 + F.lane, k0 = F.wave * 128;
        float a0 = 0.f, a1 = 0.f, a2 = 0.f, a3 = 0.f;
#pragma unroll 16
        for (int kk = 0; kk < 128; ++kk) { const float w = W[(size_t)(k0 + kk) * N + n]; a0 += cact[k0 + kk] * w; a1 += cact[1024 + k0 + kk] * w; a2 += cact[2048 + k0 + kk] * w; a3 += cact[3072 + k0 + kk] * w; }
        red[(F.wave * 4 + 0) * 64 + F.lane] = a0; red[(F.wave * 4 + 1) * 64 + F.lane] = a1; red[(F.wave * 4 + 2) * 64 + F.lane] = a2; red[(F.wave * 4 + 3) * 64 + F.lane] = a3;
        __syncthreads();
        if (F.wave < 4) { float s = bias[n];
#pragma unroll
            for (int w8 = 0; w8 < 8; ++w8) s += red[(w8 * 4 + F.wave) * 64 + F.lane];
            out[F.wave * N + n] = s; }
        __syncthreads();
    }
    {
        const int gt = F.vcu * 512 + F.tid, GT = F.G * 512;
        const float* rel_bias = I.p[2];
        float* ba = (float*)(F.ws + WS_BIASA);
        for (int i = gt; i < 8 * 4224; i += GT) { const int h = i / 4224, idx = i % 4224, dist = 4095 - idx; ba[i] = dist < 0 ? -INFINITY : rel_bias[t5_bucket(dist) * 8 + h] * LOG2E; }
        float* bb = (float*)(F.ws + WS_BIASB);
        for (int i = gt; i < 3 * 8 * 224; i += GT) { const int g = i / (8 * 224), h = (i / 224) % 8, idx = i % 224, rel = 159 - idx; const int dil = g == 0 ? 1 : (g == 1 ? 4 : 16);
            bb[i] = (rel < 0 || rel > 128) ? -INFINITY : rel_bias[t5_bucket(dil * rel) * 8 + h] * LOG2E; }
        unsigned short* rwt = (unsigned short*)(F.ws + WS_RWT);
        for (int i = gt; i < 4 * 36 * 1024; i += GT) { const int l = i / (36 * 1024), o = (i / 1024) % 36, k = i % 1024;
            const float w = o < 4 ? I.p[21][(size_t)l * 4096 + k * 4 + o] : I.p[23][(size_t)l * 32768 + k * 32 + (o - 4)];
            const unsigned hi = cvtpk_s(w, 0.f) & 0xffffu, lo = cvtpk_s(w - bf_lo(hi), 0.f) & 0xffffu;
            const int pos = o * 1024 + ((((k >> 3) ^ (o & 15)) << 3) | (k & 7));
            rwt[(size_t)l * 73728 + pos] = (unsigned short)hi; rwt[(size_t)l * 73728 + 36864 + pos] = (unsigned short)lo; }
        float* ut = (float*)(F.ws + WS_UTAB);
        for (int i = gt; i < 8 * 128; i += GT) { const int h = i >> 7, j = i & 127, d0 = 32 * j - 63;
            ut[i] = (d0 >= 0 && t5_bucket(d0) == t5_bucket(d0 + 94)) ? rel_bias[t5_bucket(d0) * 8 + h] * LOG2E : __builtin_nanf(""); }
        if (F.vcu == 1 && F.wave < 6) {
            const int J = F.wave / 3, g = F.wave % 3;
            const float gq = wave_max(fabsf(I.p[19][(J * 3 + g) * 64 + F.lane])), gk = wave_max(fabsf(I.p[17][g * 64 + F.lane]));
            const float bm = wave_max(fmaxf(fmaxf(rel_bias[F.lane], rel_bias[64 + F.lane]), fmaxf(rel_bias[128 + F.lane], rel_bias[192 + F.lane]))) * LOG2E;
            if (F.lane == 0) ((float*)(F.ws + WS_LAM))[4 + F.wave] = fmaxf(0.f, 64.f * QSCALE * gq * gk + bm - 24.f);
        }
        if (F.vcu == 0 && F.wave < 2) {
            const float* lp = I.p[10] + F.wave * 4 * 64;
            const float s1 = wave_sum(lp[F.lane] * lp[64 + F.lane]), s2 = wave_sum(lp[128 + F.lane] * lp[192 + F.lane]);
            const float lam_init = 0.8f - 0.6f * expf(-0.3f * (float)F.wave);
            if (F.lane == 0) ((float*)(F.ws + WS_LAM))[F.wave] = expf(s1) - expf(s2) + lam_init;
            const float gq = wave_max(fabsf(I.p[8][F.wave * 64 + F.lane])), gk = wave_max(fabsf(I.p[9][F.wave * 64 + F.lane]));
            const float bm = wave_max(fmaxf(fmaxf(rel_bias[F.lane], rel_bias[64 + F.lane]), fmaxf(rel_bias[128 + F.lane], rel_bias[192 + F.lane]))) * LOG2E;
            if (F.lane == 0) ((float*)(F.ws + WS_LAM))[2 + F.wave] = fmaxf(0.f, 64.f * QSCALE * gq * gk + bm - 24.f);
        }
    }
    __syncthreads();
    LAS float* scr = (LAS float*)(F.lds + F.wave * 16384);
    const int gw = F.vcu * 8 + F.wave, NGW = F.G * 8;
    constexpr int I_QKVA = 16 * 96, I_OA = 16 * 32, I_KV = 16 * 96, I_QB = 16 * 48, I_OB = 8 * 32;
    constexpr int N_DENSE = 2 * I_QKVA + 2 * I_OA + I_KV + 2 * I_QB + 2 * I_OB;
    for (int it = gw; it < N_DENSE; it += NGW) {
        int r = it;
        if (r < 2 * I_QKVA) { const int l = r / I_QKVA; r %= I_QKVA; const int kb = r / 96, nb = r % 96, n0 = nb * 32;
            p0_transpose_item(I.p[7] + (size_t)l * 1024 * 3072, 1024, 3072, (bf16*)(F.ws + WS_WQKVA) + (size_t)l * 3072 * 1024, kb * 64, n0, headperm_row(n0), scr, F.lane); continue; } r -= 2 * I_QKVA;
        if (r < 2 * I_OA) { const int l = r / I_OA; r %= I_OA; const int kb = r / 32, nb = r % 32, n0 = nb * 32;
            p0_transpose_item(I.p[12] + (size_t)l * 1024 * 1024, 1024, 1024, (bf16*)(F.ws + WS_WOA) + (size_t)l * 1024 * 1024, kb * 64, n0, n0, scr, F.lane); continue; } r -= 2 * I_OA;
        if (r < I_KV) { const int kb = r / 96, nb = r % 96, n0 = nb * 32;
            p0_transpose_item(I.p[16], 1024, 3072, (bf16*)(F.ws + WS_WKV), kb * 64, n0, headperm_row(n0), scr, F.lane); continue; } r -= I_KV;
        if (r < 2 * I_QB) { const int l = r / I_QB; r %= I_QB; const int kb = r / 48, nb = r % 48, n0 = nb * 32;
            p0_transpose_item(I.p[18] + (size_t)l * 1024 * 1536, 1024, 1536, (bf16*)(F.ws + WS_WQB) + (size_t)l * 1536 * 1024, kb * 64, n0, headperm_row(n0), scr, F.lane); continue; } r -= 2 * I_QB;
        { const int l = r / I_OB; r %= I_OB; const int kb = r / 32, nb = r % 32, n0 = nb * 32;
            p0_transpose_item(I.p[20] + (size_t)l * 512 * 1024, 512, 1024, (bf16*)(F.ws + WS_WOB) + (size_t)l * 1024 * 512, kb * 64, n0, n0, scr, F.lane); }
    }
}

__device__ __forceinline__ void unpack8(const v4u q, f32x4& lo, f32x4& hi) { lo = (f32x4){bf_lo(q.x), bf_hi(q.x), bf_lo(q.y), bf_hi(q.y)}; hi = (f32x4){bf_lo(q.z), bf_hi(q.z), bf_lo(q.w), bf_hi(q.w)}; }
__device__ __forceinline__ v4u pack8(const f32x4 lo, const f32x4 hi) { v4u w; w.x = cvt_pk_bf16(lo.x, lo.y); w.y = cvt_pk_bf16(lo.z, lo.w); w.z = cvt_pk_bf16(hi.x, hi.y); w.w = cvt_pk_bf16(hi.z, hi.w); return w; }
template <bool XF32> __device__ __forceinline__ void norm_phase(Frame& F, const void* xin_, bf16* xout, const bf16* yb, const float* ygate, const float* gain, const float* shift, const float* scale, int mstride, bf16* hn,
                                            const float* gain2, const float* shift2, const float* scale2, int mstride2, bf16* hn2) {
    const int gw = F.vcu * 8 + F.wave, b = gw >> 9, row0 = b * 4096 + (gw & 511);
    f32x4 gfv[2][2], Av[2][2], Sv[2][2], A2[2][2], S2[2][2];
#pragma unroll
    for (int j = 0; j < 2; ++j)
#pragma unroll
        for (int q = 0; q < 2; ++q) { const int c = 8 * F.lane + 512 * j + 4 * q; const f32x4 z = {0.f, 0.f, 0.f, 0.f};
            gfv[j][q] = yb ? *(const GAS f32x4*)(ygate + b * 6144 + c) : z;
            if (hn) { const f32x4 g = *(const GAS f32x4*)(gain + c), sc = *(const GAS f32x4*)(scale + b * mstride + c); Av[j][q] = g * (sc + 1.f); Sv[j][q] = *(const GAS f32x4*)(shift + b * mstride + c); }
            else { Av[j][q] = z; Sv[j][q] = z; }
            if (hn2) { const f32x4 g = *(const GAS f32x4*)(gain2 + c), sc = *(const GAS f32x4*)(scale2 + b * mstride2 + c); A2[j][q] = g * (sc + 1.f); S2[j][q] = *(const GAS f32x4*)(shift2 + b * mstride2 + c); }
            else { A2[j][q] = z; S2[j][q] = z; } }
    f32x4 xf[2][2]; v4u xq[2], yq[2][2];
    const v4u z4 = {0u, 0u, 0u, 0u};
#define NP_LOAD(r_) do { _Pragma("unroll") for (int j = 0; j < 2; ++j) { const int c = 8 * F.lane + 512 * j; \
        if (XF32) { xf[j][0] = *(const GAS f32x4*)((const float*)xin_ + (size_t)(r_) * D + c); xf[j][1] = *(const GAS f32x4*)((const float*)xin_ + (size_t)(r_) * D + c + 4); xq[j] = z4; } \
        else xq[j] = *(const GAS v4u*)((const bf16*)xin_ + (size_t)(r_) * D + c); \
        if (yb) { yq[j][0] = *(const GAS v4u*)(yb + (size_t)(r_) * 2048 + c); yq[j][1] = *(const GAS v4u*)(yb + (size_t)(r_) * 2048 + 1024 + c); } else { yq[j][0] = z4; yq[j][1] = z4; } } } while (0)
    NP_LOAD(row0);
#pragma unroll 1
    for (int k = 0; k < 8; ++k) {
        const int row = row0 + 512 * k;
        f32x4 v[2][2]; v4u yc[2][2]; float ss = 0.f;
#pragma unroll
        for (int j = 0; j < 2; ++j) { if (XF32) { v[j][0] = xf[j][0]; v[j][1] = xf[j][1]; } else unpack8(xq[j], v[j][0], v[j][1]); yc[j][0] = yq[j][0]; yc[j][1] = yq[j][1]; }
        if (k + 1 < 8) NP_LOAD(row + 512);
        if (yb) {
#pragma unroll
            for (int j = 0; j < 2; ++j) { f32x4 a0, a1, b0, b1; unpack8(yc[j][0], a0, a1); unpack8(yc[j][1], b0, b1);
                v[j][0] += gfv[j][0] * (a0 + b0); v[j][1] += gfv[j][1] * (a1 + b1); }
        }
        if (xout) {
#pragma unroll
            for (int j = 0; j < 2; ++j) { const v4u xb = pack8(v[j][0], v[j][1]); *(GAS v4u*)(xout + (size_t)row * D + 8 * F.lane + 512 * j) = xb;
                unpack8(xb, v[j][0], v[j][1]); }
        }
#pragma unroll
        for (int j = 0; j < 2; ++j)
#pragma unroll
            for (int q = 0; q < 2; ++q) ss += (v[j][q].x * v[j][q].x + v[j][q].y * v[j][q].y) + (v[j][q].z * v[j][q].z + v[j][q].w * v[j][q].w);
        const float rinv = __builtin_amdgcn_rsqf(wave_sum(ss) * (1.f / D) + EPS);
        if (hn) {
#pragma unroll
            for (int j = 0; j < 2; ++j) *(GAS v4u*)(hn + (size_t)row * D + 8 * F.lane + 512 * j) = pack8(v[j][0] * rinv * Av[j][0] + Sv[j][0], v[j][1] * rinv * Av[j][1] + Sv[j][1]);
        }
        if (hn2) {
#pragma unroll
            for (int j = 0; j < 2; ++j) *(GAS v4u*)(hn2 + (size_t)row * D + 8 * F.lane + 512 * j) = pack8(v[j][0] * rinv * A2[j][0] + S2[j][0], v[j][1] * rinv * A2[j][1] + S2[j][1]);
        }
    }
#undef NP_LOAD
}

__device__ __forceinline__ void router_phase(Frame& F, const bf16* x, int rowblk, gu32* xcnt, gu32* tmo, const float* gain, const float* shift, const float* scale, bf16* hn,
                                              const float* wT, const float* bg, const float* be, gu32* gcnt, int* rowtok, float* roww, int pm = 0) {
#ifndef PROBE_R_MODE
    (void)pm;
#define RPM(bit) false
#else
#define RPM(bit) ((pm & (bit)) != 0)
#endif
    LAS char* wl = (LAS char*)(F.lds);
    LAS float* AS = (LAS float*)(F.lds + TOKL_OFF);
    LAS int* lcnt = (LAS int*)(F.lds + HIST_OFF);
    LAS float* ssx = (LAS float*)(F.lds + REC_OFF);
    LAS float* lbias = (LAS float*)(F.lds + MT_OFF);
    const int b = (rowblk * 64) >> 12;
    if (!RPM(1)) { f32x4 tw[18];
#pragma unroll
      for (int i = 0; i < 18; ++i) tw[i] = *(const GAS f32x4*)(wT + 4 * (F.tid + 512 * i));
      const int c = 4 * (F.tid & 255);
      const f32x4 g = *(const GAS f32x4*)(gain + c), sc = *(const GAS f32x4*)(scale + b * 6144 + c), sh = *(const GAS f32x4*)(shift + b * 6144 + c);
      float lb = 0.f; if (F.tid < 4) lb = bg[F.tid]; else if (F.tid < 36) lb = be[F.tid - 4];
#pragma unroll
      for (int i = 0; i < 18; ++i) *(LAS f32x4*)((LAS float*)wl + 4 * (F.tid + 512 * i)) = tw[i];
      if (F.tid < 256) { *(LAS f32x4*)(AS + c) = g * (sc + 1.f); *(LAS f32x4*)(AS + 1024 + c) = sh; }
      if (F.tid < 36) lbias[F.tid] = lb; }
    if (F.tid < 64) lcnt[F.tid] = 0;
    if (xcnt) {
        gu32* c = xcnt + (rowblk >> 2) * 16; unsigned sp = 0;
        while (__hip_atomic_load(c, RLX_AGENT) < 32u) { __builtin_amdgcn_s_sleep(2);
            if ((++sp & 63u) == 0u) { if (__hip_atomic_load(tmo, RLX_AGENT) != 0u) break; if (sp > (1u << 17)) { __hip_atomic_store(tmo, 0xACEu, RLX_AGENT); break; } } }
    }
    const int mt = F.wave & 3, kh = F.wave >> 2, li = F.lane & 15, kq = F.lane >> 4;
    const int row = rowblk * 64 + mt * 16 + li, kbase = 512 * kh + 8 * kq;
    const __amdgpu_buffer_rsrc_t xrs = __builtin_amdgcn_make_buffer_rsrc((void*)x, 0, 32 << 20, 0x00020000);
    v4u xr[16];
#pragma unroll
    for (int s = 0; s < 16; ++s) xr[s] = RPM(2) ? (v4u){0x3f803f80u, 0x3f803f80u, 0x3f803f80u, 0x3f803f80u} : __builtin_bit_cast(v4u, __builtin_amdgcn_raw_buffer_load_b128(xrs, (unsigned)(row * D + kbase + 32 * s) * 2u, 0, 16));
    float ss = 0.f;
#pragma unroll
    for (int s = 0; s < 16; ++s) { const v4u q = xr[s];
        const float a0 = bf_lo(q.x), a1 = bf_hi(q.x), a2 = bf_lo(q.y), a3 = bf_hi(q.y), a4 = bf_lo(q.z), a5 = bf_hi(q.z), a6 = bf_lo(q.w), a7 = bf_hi(q.w);
        ss += ((a0 * a0 + a1 * a1) + (a2 * a2 + a3 * a3)) + ((a4 * a4 + a5 * a5) + (a6 * a6 + a7 * a7)); }
    ss += __builtin_bit_cast(float, __builtin_amdgcn_ds_bpermute((F.lane ^ 16) << 2, __builtin_bit_cast(int, ss)));
    ss += __builtin_bit_cast(float, __builtin_amdgcn_ds_bpermute((F.lane ^ 32) << 2, __builtin_bit_cast(int, ss)));
    if (kq == 0) ssx[F.wave * 16 + li] = ss;
    __syncthreads();
    const float rinv = __builtin_amdgcn_rsqf((ssx[F.wave * 16 + li] + ssx[(F.wave ^ 4) * 16 + li]) * (1.f / D) + EPS);
    f32x4 acc[3];
#pragma unroll
    for (int n = 0; n < 3; ++n) acc[n] = (f32x4){0.f, 0.f, 0.f, 0.f};
    int wrow[3];
#pragma unroll
    for (int n = 0; n < 3; ++n) { const int o = (16 * n + li) > 35 ? 35 : (16 * n + li); wrow[n] = o * 2048; }
    bf16* hrow = hn + (size_t)row * D + kbase;
    if (!RPM(4))
#pragma unroll
    for (int s = 0; s < 16; ++s) {
        const int k0 = kbase + 32 * s, chunk = (64 * kh + 4 * s + kq) ^ li;
        const f32x4 A0 = *(const LAS f32x4*)(AS + k0), A1 = *(const LAS f32x4*)(AS + k0 + 4), S0 = *(const LAS f32x4*)(AS + 1024 + k0), S1 = *(const LAS f32x4*)(AS + 1024 + k0 + 4);
        const v4u q = xr[s];
        const f32x4 h0 = (f32x4){bf_lo(q.x), bf_hi(q.x), bf_lo(q.y), bf_hi(q.y)} * rinv * A0 + S0, h1 = (f32x4){bf_lo(q.z), bf_hi(q.z), bf_lo(q.w), bf_hi(q.w)} * rinv * A1 + S1;
        v4u hw; hw.x = cvt_pk_bf16(h0.x, h0.y); hw.y = cvt_pk_bf16(h0.z, h0.w); hw.z = cvt_pk_bf16(h1.x, h1.y); hw.w = cvt_pk_bf16(h1.z, h1.w);
        *(GAS v4u*)(hrow + 32 * s) = hw;
        v4u lw; lw.x = cvt_pk_bf16(h0.x - bf_lo(hw.x), h0.y - bf_hi(hw.x)); lw.y = cvt_pk_bf16(h0.z - bf_lo(hw.y), h0.w - bf_hi(hw.y));
        lw.z = cvt_pk_bf16(h1.x - bf_lo(hw.z), h1.y - bf_hi(hw.z)); lw.w = cvt_pk_bf16(h1.z - bf_lo(hw.w), h1.w - bf_hi(hw.w));
        const bf16x8 ah = __builtin_bit_cast(bf16x8, hw), al = __builtin_bit_cast(bf16x8, lw);
#pragma unroll
        for (int n = 0; n < 3; ++n) { const LAS char* wp = wl + wrow[n] + chunk * 16;
            const bf16x8 bh = *(const LAS bf16x8*)(wp), bl = *(const LAS bf16x8*)(wp + 73728);
            acc[n] = __builtin_amdgcn_mfma_f32_16x16x32_bf16(ah, bh, acc[n], 0, 0, 0);
            acc[n] = __builtin_amdgcn_mfma_f32_16x16x32_bf16(al, bh, acc[n], 0, 0, 0);
            acc[n] = __builtin_amdgcn_mfma_f32_16x16x32_bf16(ah, bl, acc[n], 0, 0, 0); }
    }
    __syncthreads();
    LAS float* lg = (LAS float*)(F.lds);
#pragma unroll
    for (int n = 0; n < 3; ++n) { const int col = 16 * n + li;
        if (col < 36) {
#pragma unroll
            for (int e = 0; e < 4; ++e) lg[(kh * 64 + mt * 16 + 4 * kq + e) * 37 + col] = acc[n][e]; } }
    __syncthreads();
    int e0 = 0, e1 = 0, s0 = 0, s1 = 0; float w0 = 0.f, w1 = 0.f;
    if (F.tid < 64 && !RPM(8)) {
        const LAS float* l0 = lg + F.tid * 37; const LAS float* l1 = lg + (64 + F.tid) * 37;
        float gl[4];
#pragma unroll
        for (int o = 0; o < 4; ++o) gl[o] = (l0[o] + l1[o]) + lbias[o];
        int gi = 0; float gm = gl[0];
#pragma unroll
        for (int o = 1; o < 4; ++o) if (gl[o] > gm) { gm = gl[o]; gi = o; }
        float gden = 0.f;
#pragma unroll
        for (int o = 0; o < 4; ++o) gden += __expf(gl[o] - gm);
        const float g_w = 1.f / gden;
        float el[8];
#pragma unroll
        for (int o = 0; o < 8; ++o) el[o] = (l0[4 + gi * 8 + o] + l1[4 + gi * 8 + o]) + lbias[4 + gi * 8 + o];
        int i0 = 0; float v0 = el[0];
#pragma unroll
        for (int o = 1; o < 8; ++o) if (el[o] > v0) { v0 = el[o]; i0 = o; }
        int i1 = -1; float v1 = -INFINITY;
#pragma unroll
        for (int o = 0; o < 8; ++o) if (o != i0 && el[o] > v1) { v1 = el[o]; i1 = o; }
        w0 = g_w / (1.f + __expf(v1 - v0)); w1 = g_w - w0;
        e0 = gi * 8 + i0; e1 = gi * 8 + i1;
        s0 = __hip_atomic_fetch_add(lcnt + e0, 1, __ATOMIC_RELAXED, __HIP_MEMORY_SCOPE_WORKGROUP); s1 = __hip_atomic_fetch_add(lcnt + e1, 1, __ATOMIC_RELAXED, __HIP_MEMORY_SCOPE_WORKGROUP);
    }
    __syncthreads();
    if (F.tid < 32 && !RPM(8)) { const int c = lcnt[F.tid]; lcnt[32 + F.tid] = c ? (int)__hip_atomic_fetch_add(gcnt + F.tid * 64, (unsigned)c, RLX_AGENT) : 0; }
    __syncthreads();
    if (F.tid < 64 && !RPM(8)) { const int r = rowblk * 64 + F.tid; s0 += lcnt[32 + e0]; s1 += lcnt[32 + e1];
        rowtok[e0 * ROWCAP + s0] = r * 2; roww[e0 * ROWCAP + s0] = w0;
        rowtok[e1 * ROWCAP + s1] = r * 2 + 1; roww[e1 * ROWCAP + s1] = w1; }
    __syncthreads();
}
#undef RPM

__device__ __forceinline__ void combine_phase(Frame& F, const bf16* og, const float* lse, bf16* ob) {
    const int gw = F.vcu * 8 + F.wave, NGW = F.G * 8;
    for (int row = gw; row < T; row += NGW) {
        const int h = F.lane >> 3;
        float l[3], w[3];
#pragma unroll
        for (int g = 0; g < 3; ++g) l[g] = lse[((size_t)g * T + row) * 8 + h];
        const float mx = fmaxf(l[0], fmaxf(l[1], l[2]));
        float den = 0.f;
#pragma unroll
        for (int g = 0; g < 3; ++g) { w[g] = __builtin_amdgcn_exp2f(l[g] - mx); den += w[g]; }
        const float inv = 1.f / den;
        float acc[8];
#pragma unroll
        for (int i = 0; i < 8; ++i) acc[i] = 0.f;
#pragma unroll
        for (int g = 0; g < 3; ++g) { const v4u o = *(const GAS v4u*)(og + ((size_t)g * T + row) * 512 + 8 * F.lane); const float wg_ = w[g] * inv;
            acc[0] += wg_ * bf_lo(o.x); acc[1] += wg_ * bf_hi(o.x); acc[2] += wg_ * bf_lo(o.y); acc[3] += wg_ * bf_hi(o.y);
            acc[4] += wg_ * bf_lo(o.z); acc[5] += wg_ * bf_hi(o.z); acc[6] += wg_ * bf_lo(o.w); acc[7] += wg_ * bf_hi(o.w); }
        v4u r; r.x = cvt_pk_bf16(acc[0], acc[1]); r.y = cvt_pk_bf16(acc[2], acc[3]); r.z = cvt_pk_bf16(acc[4], acc[5]); r.w = cvt_pk_bf16(acc[6], acc[7]);
        *(GAS v4u*)(ob + (size_t)row * 512 + 8 * F.lane) = r;
    }
}

__device__ __forceinline__ void final_phase(Frame& F, const bf16* x, const bf16* yb, const float* ygate, float* xo) {
    const int gw = F.vcu * 8 + F.wave, b = gw >> 9, row0 = b * 4096 + (gw & 511);
    f32x4 gfv[2][2];
#pragma unroll
    for (int j = 0; j < 2; ++j)
#pragma unroll
        for (int q = 0; q < 2; ++q) gfv[j][q] = *(const GAS f32x4*)(ygate + b * 6144 + 8 * F.lane + 512 * j + 4 * q);
    v4u xq[2], yq[2][2];
#define FP_LOAD(r_) do { _Pragma("unroll") for (int j = 0; j < 2; ++j) { const int c = 8 * F.lane + 512 * j; xq[j] = *(const GAS v4u*)(x + (size_t)(r_) * D + c); \
        yq[j][0] = *(const GAS v4u*)(yb + (size_t)(r_) * 2048 + c); yq[j][1] = *(const GAS v4u*)(yb + (size_t)(r_) * 2048 + 1024 + c); } } while (0)
    FP_LOAD(row0);
#pragma unroll 1
    for (int k = 0; k < 8; ++k) { const int row = row0 + 512 * k;
        v4u xc[2], yc[2][2];
#pragma unroll
        for (int j = 0; j < 2; ++j) { xc[j] = xq[j]; yc[j][0] = yq[j][0]; yc[j][1] = yq[j][1]; }
        if (k + 1 < 8) FP_LOAD(row + 512);
#pragma unroll
        for (int j = 0; j < 2; ++j) { const int c = 8 * F.lane + 512 * j; f32x4 v0, v1, a0, a1, b0, b1;
            unpack8(xc[j], v0, v1); unpack8(yc[j][0], a0, a1); unpack8(yc[j][1], b0, b1);
            *(GAS f32x4*)(xo + (size_t)row * D + c) = v0 + gfv[j][0] * (a0 + b0); *(GAS f32x4*)(xo + (size_t)row * D + c + 4) = v1 + gfv[j][1] * (a1 + b1); }
    }
#undef FP_LOAD
}

struct EpiHN {
    static constexpr bool PERM = true;
    bf16* out0; size_t sec_stride; const float* gain0; long gdelta; int nnorm; float scale0; int tiles_per_sec, ld, gshift, dilated;
    int pskip;
    __device__ __forceinline__ void operator()(const f32x4 (&acc)[2][2][4][2], const pg8::Unit& u, int, int wr, int wc, int fr, int fq) const {
#ifdef PROBE_EPI_MODE
        if (pskip == 1) return;
#endif
        const int sec = u.pn / tiles_per_sec, pnl = u.pn - sec * tiles_per_sec;
        bf16* out = out0 + (size_t)sec * sec_stride;
        const bool nrm = sec < nnorm;
        const float scl = sec == 0 ? scale0 : 1.f;
        const int col0 = 256 * pnl + 64 * wc;
        f32x4 gv[2][2];
#pragma unroll
        for (int bj = 0; bj < 2; ++bj)
#pragma unroll
            for (int n = 0; n < 2; ++n) gv[bj][n] = nrm ? *(const f32x4*)(gain0 + (long)sec * gdelta + (col0 >> gshift) * 64 + 8 * fq + 32 * bj + 4 * n) * scl : (f32x4){1.f, 1.f, 1.f, 1.f};
#pragma unroll
        for (int ai = 0; ai < 2; ++ai)
#pragma unroll
            for (int m = 0; m < 4; ++m) {
                const int row = u.pm * 256 + ai * 128 + wr * 64 + m * 16 + fr;
                float rinv = 1.f;
                if (nrm) { float ss = 0.f;
#pragma unroll
                    for (int bj = 0; bj < 2; ++bj)
#pragma unroll
                        for (int n = 0; n < 2; ++n) { const f32x4 a = acc[ai][bj][m][n]; ss += (a.x * a.x + a.y * a.y) + (a.z * a.z + a.w * a.w); }
                    rinv = __builtin_amdgcn_rsqf(quad16_sum(ss) * (1.f / 64.f) + EPS); }
                bf16* orow;
                if (dilated) { const int g = col0 >> 9, hh = (col0 >> 6) & 7, sh = 2 * g, bb = row >> 12, s = row & 4095;
                    orow = out + ((size_t)(((g * 8 + hh) * 4 + bb) * 4096 + (s & ((1 << sh) - 1)) * (4096 >> sh) + (s >> sh))) * 64 + 8 * fq; }
                else orow = out + (size_t)row * ld + col0 + 8 * fq;
#pragma unroll
                for (int bj = 0; bj < 2; ++bj) { const f32x4 v0 = acc[ai][bj][m][0] * (gv[bj][0] * rinv), v1 = acc[ai][bj][m][1] * (gv[bj][1] * rinv);
                    v4u w; w.x = cvt_pk_bf16(v0.x, v0.y); w.y = cvt_pk_bf16(v0.z, v0.w); w.z = cvt_pk_bf16(v1.x, v1.y); w.w = cvt_pk_bf16(v1.z, v1.w);
#ifdef PROBE_EPI_MODE
                    if (pskip != 2)
#endif
                    *(v4u*)(orow + 32 * bj) = w; }
            }
    }
};
template <bool XF32> struct EpiResid {
    static constexpr bool PERM = true;
    const void* xin_; bf16* xout; const float* gate; gu32* cnt;
    __device__ __forceinline__ void operator()(const f32x4 (&acc)[2][2][4][2], const pg8::Unit& u, int, int wr, int wc, int fr, int fq) const {
        const int b = (u.pm * 256) >> 12, c0 = 256 * u.pn + 32 * wc + 8 * fq;
        const __amdgpu_buffer_rsrc_t rs = __builtin_amdgcn_make_buffer_rsrc(xout, 0, 32 << 20, 0x00020000);
        f32x4 gg[2][2];
#pragma unroll
        for (int bj = 0; bj < 2; ++bj)
#pragma unroll
            for (int n = 0; n < 2; ++n) gg[bj][n] = *(const f32x4*)(gate + b * 6144 + c0 + 128 * bj + 4 * n);
#pragma unroll
        for (int ai = 0; ai < 2; ++ai) {
            f32x4 xo[4][2][2];
#pragma unroll
            for (int m = 0; m < 4; ++m) { const size_t ro = (size_t)(u.pm * 256 + ai * 128 + wr * 64 + m * 16 + fr) * D + c0;
#pragma unroll
                for (int bj = 0; bj < 2; ++bj) {
                    if (XF32) { xo[m][bj][0] = *(const f32x4*)((const float*)xin_ + ro + 128 * bj); xo[m][bj][1] = *(const f32x4*)((const float*)xin_ + ro + 128 * bj + 4); }
                    else { const v4u xb = *(const v4u*)((const bf16*)xin_ + ro + 128 * bj);
                        xo[m][bj][0] = (f32x4){bf_lo(xb.x), bf_hi(xb.x), bf_lo(xb.y), bf_hi(xb.y)}; xo[m][bj][1] = (f32x4){bf_lo(xb.z), bf_hi(xb.z), bf_lo(xb.w), bf_hi(xb.w)}; } } }
#pragma unroll
            for (int m = 0; m < 4; ++m) { const size_t ro = (size_t)(u.pm * 256 + ai * 128 + wr * 64 + m * 16 + fr) * D + c0;
#pragma unroll
                for (int bj = 0; bj < 2; ++bj) { const f32x4 r0 = xo[m][bj][0] + gg[bj][0] * acc[ai][bj][m][0], r1 = xo[m][bj][1] + gg[bj][1] * acc[ai][bj][m][1];
                    v4u w; w.x = cvt_pk_bf16(r0.x, r0.y); w.y = cvt_pk_bf16(r0.z, r0.w); w.z = cvt_pk_bf16(r1.x, r1.y); w.w = cvt_pk_bf16(r1.z, r1.w);
                    __builtin_amdgcn_raw_buffer_store_b128(w, rs, (unsigned)(ro + 128 * bj) * 2u, 0, 16); } }
        }
        asm volatile("s_waitcnt vmcnt(0)" ::: "memory");
        if (fr == 0 && fq == 0) __hip_atomic_fetch_add(cnt + u.pm * 16, 1u, RLX_AGENT);
    }
};
struct EpiMoeGU {
    static constexpr bool PERM = true;
    bf16* act; gu32* cnt;
    __device__ __forceinline__ void operator()(const f32x4 (&acc)[2][2][4][2], const pg8::Unit& u, int, int wr, int wc, int fr, int fq) const {
        const int pnl = u.pn & 3;
        const __amdgpu_buffer_rsrc_t rs = __builtin_amdgcn_make_buffer_rsrc(act, 0, 44 << 20, 0x00020000);
#pragma unroll
        for (int ai = 0; ai < 2; ++ai) { if (ai == 1 && u.h) break;
#pragma unroll
            for (int m = 0; m < 4; ++m) {
                const int row = u.pm * 256 + ai * 128 + wr * 64 + m * 16 + fr;
                float r[8];
#pragma unroll
                for (int n = 0; n < 2; ++n)
#pragma unroll
                    for (int e = 0; e < 4; ++e) { const float g = acc[ai][0][m][n][e], up = acc[ai][1][m][n][e]; r[4 * n + e] = g * __builtin_amdgcn_rcpf(1.f + __expf(-g)) * up; }
                v4u w; w.x = cvt_pk_bf16(r[0], r[1]); w.y = cvt_pk_bf16(r[2], r[3]); w.z = cvt_pk_bf16(r[4], r[5]); w.w = cvt_pk_bf16(r[6], r[7]);
                __builtin_amdgcn_raw_buffer_store_b128(w, rs, (unsigned)(row * 512 + 128 * pnl + 32 * wc + 8 * fq) * 2u, 0, 16);
            } }
        asm volatile("s_waitcnt vmcnt(0)" ::: "memory");
        if (fr == 0 && fq == 0) __hip_atomic_fetch_add(cnt + u.pm * 16, 1u, RLX_AGENT);
    }
};
struct EpiMoeDown {
    static constexpr bool PERM = true;
    bf16* yb; const LAS int* tokl; const LAS float* wl;
    __device__ __forceinline__ void operator()(const f32x4 (&acc)[2][2][4][2], const pg8::Unit& u, int ui, int wr, int wc, int fr, int fq) const {
        const int pnl = u.pn & 3;
#pragma unroll
        for (int ai = 0; ai < 2; ++ai)
#pragma unroll
            for (int m = 0; m < 4; ++m) {
                const int r = ai * 128 + wr * 64 + m * 16 + fr;
                const int tk = tokl[(ui & 3) * 256 + r]; const float w = wl[(ui & 3) * 256 + r];
                if (tk >= 0) {
#pragma unroll
                    for (int bj = 0; bj < 2; ++bj) { const int c = 256 * pnl + 128 * bj + 32 * wc + 8 * fq;
                        const f32x4 v0 = acc[ai][bj][m][0] * w, v1 = acc[ai][bj][m][1] * w;
                        v4u o; o.x = cvt_pk_bf16(v0.x, v0.y); o.y = cvt_pk_bf16(v0.z, v0.w); o.z = cvt_pk_bf16(v1.x, v1.y); o.w = cvt_pk_bf16(v1.z, v1.w);
                        *(v4u*)(yb + (size_t)tk * 1024 + c) = o; }
                }
            }
    }
};

struct MoeOrder {
    const LAS int* ul; const LAS int* tokl; int K2; gu32* cnt; gu32* tmo;
    __device__ __forceinline__ bool next(int i, pg8::Unit& u) const {
        if (i >= 4) return false;
        const LAS int* d = ul + i * 8; if (!d[0]) return false;
        u.pm = d[1]; u.pn = d[2]; u.e = d[3]; u.rt = d[4]; u.h = d[5]; return true;
    }
    __device__ __forceinline__ unsigned goff(int ui, int row) const { const int tk = tokl[(ui & 3) * 256 + row]; return (unsigned)((tk < 0 ? 0 : (tk >> 1)) * K2); }
};
struct MoeOrderG : MoeOrder { static constexpr bool GATHER = true, MOE = true, A_SC1 = false; __device__ __forceinline__ void wait_ready(const pg8::Unit&) const {}
    __device__ __forceinline__ unsigned poll(const pg8::Unit&) const { return 0u; } __device__ __forceinline__ void wait_polled(const pg8::Unit&, unsigned) const {} };
struct MoeOrderC : MoeOrder { static constexpr bool GATHER = false, MOE = true, A_SC1 = false;
    __device__ __forceinline__ void wait_ready(const pg8::Unit& u) const {
        gu32* c = cnt + u.pm * 16; unsigned sp = 0;
        while (__hip_atomic_load(c, RLX_AGENT) < 32u) { __builtin_amdgcn_s_sleep(2);
            if ((++sp & 63u) == 0u) { if (__hip_atomic_load(tmo, RLX_AGENT) != 0u) break; if (sp > (1u << 17)) { __hip_atomic_store(tmo, 0xACDu, RLX_AGENT); break; } } }
    }
    __device__ __forceinline__ unsigned poll(const pg8::Unit& u) const { return __hip_atomic_load(cnt + u.pm * 16, RLX_AGENT); }
    __device__ __forceinline__ void wait_polled(const pg8::Unit& u, unsigned v) const { if (v < 32u) wait_ready(u); }
};

__device__ __forceinline__ void moe_decode(const LAS int* mt, int L, int nfull, int nhalf, LAS int* d) {
    int valid = 0, pm = 0, pn = 0, ue = 0, rt = 0, hh = 0;
    if (L >= 0 && L < 4 * (nfull + nhalf)) {
        valid = 1; const int tI = L >> 2, pnl = L & 3; int acc_t = 0, pstart = 0; bool found = false;
        if (tI < nfull) {
            for (int e = 0; e < 32 && !found; ++e) { const int c = mt[64 + e], tl = (c + 255) >> 8, lastrows = c - 256 * (tl - 1), hf = (tl > 0 && lastrows <= 128) ? 1 : 0, nf = tl - hf;
                if (tI < acc_t + nf) { ue = e; rt = tI - acc_t; pm = pstart + rt; hh = 0; found = true; } acc_t += nf; pstart += tl; }
        } else {
            const int th = tI - nfull;
            for (int e = 0; e < 32 && !found; ++e) { const int c = mt[64 + e], tl = (c + 255) >> 8, lastrows = c - 256 * (tl - 1), hf = (tl > 0 && lastrows <= 128) ? 1 : 0;
                if (hf && th == acc_t) { ue = e; rt = tl - 1; pm = pstart + rt; hh = 1; found = true; } acc_t += hf; pstart += tl; }
        }
        pn = ue * 4 + pnl;
    }
    d[0] = valid; d[1] = pm; d[2] = pn; d[3] = ue; d[4] = rt; d[5] = hh;
}

__device__ __forceinline__ void moe_tables(Frame& F, const gu32* gcnt, const int* rowtok, const float* roww) {
    LAS int* mt = (LAS int*)(F.lds + MT_OFF);
    LAS int* ul = (LAS int*)(F.lds + ULIST_OFF);
    LAS int* tokl = (LAS int*)(F.lds + TOKL_OFF); LAS int* tokl2 = (LAS int*)(F.lds + TOKL2_OFF); LAS float* wl = (LAS float*)(F.lds + WL_OFF);
    if (F.tid < 32) mt[64 + F.tid] = (int)__hip_atomic_load(gcnt + F.tid * 64, RLX_AGENT);
    __syncthreads();
    if (F.tid < 8) {
        int nfull = 0, nhalf = 0;
        for (int e = 0; e < 32; ++e) { const int c = mt[64 + e], tl = (c + 255) >> 8, lastrows = c - 256 * (tl - 1), hf = (tl > 0 && lastrows <= 128) ? 1 : 0; nfull += tl - hf; nhalf += hf; }
        const int U = 4 * (nfull + nhalf), G = F.G, c = F.vcu, i = F.tid & 3;
        int L;
        if (F.tid < 4) L = i * G + c;
        else {
            int extra = U - 2 * G; extra = extra < 0 ? 0 : (extra > G / 2 ? G / 2 : extra); const int NL = G - extra;
            if (c >= extra) L = i == 0 ? c - extra : (i == 1 ? NL + c : NL + G + (c - extra) + (i - 2) * NL);
            else L = i == 0 ? NL + c : -1;
        }
        moe_decode(mt, L, nfull, nhalf, ul + F.tid * 8);
    }
    __syncthreads();
    if (F.tid < 256) {
#pragma unroll
        for (int ui = 0; ui < 8; ++ui) { const LAS int* d = ul + ui * 8;
            if (d[0]) { const int e = d[3], idx = d[4] * 256 + F.tid; const bool ok = idx < mt[64 + e];
                const int tk = ok ? rowtok[e * ROWCAP + idx] : -1;
                if (ui < 4) tokl[ui * 256 + F.tid] = tk; else { tokl2[(ui - 4) * 256 + F.tid] = tk; wl[(ui - 4) * 256 + F.tid] = ok ? roww[e * ROWCAP + idx] : 0.f; } } }
    }
    __syncthreads();
}

namespace att {
__device__ __forceinline__ s16x4 vtr(const LAS char* p) { return __builtin_bit_cast(s16x4, __builtin_amdgcn_ds_read_tr16_b64_v4i16((LAS s16x4*)p)); }
__device__ __forceinline__ bf16x8 pack8(const f32x16& p, int s) {
    v4u w; w.x = cvtpk_s(p[8 * s + 0], p[8 * s + 1]); w.y = cvtpk_s(p[8 * s + 2], p[8 * s + 3]); w.z = cvtpk_s(p[8 * s + 4], p[8 * s + 5]); w.w = cvtpk_s(p[8 * s + 6], p[8 * s + 7]);
    return __builtin_bit_cast(bf16x8, w);
}
__device__ __forceinline__ float max16(const f32x16& p) {
    float a = fmaxf(fmaxf(p[0], p[1]), fmaxf(p[2], p[3])), b = fmaxf(fmaxf(p[4], p[5]), fmaxf(p[6], p[7]));
    float c = fmaxf(fmaxf(p[8], p[9]), fmaxf(p[10], p[11])), d = fmaxf(fmaxf(p[12], p[13]), fmaxf(p[14], p[15]));
    return fmaxf(fmaxf(a, b), fmaxf(c, d));
}
#define OFFR(r) (((r) & 3) + 8 * ((r) >> 2))

constexpr int A_KSTR = 272, A_VSTR = 320, A_BT_OFF = 2 * 64 * A_KSTR + 2 * 64 * A_VSTR, A_BT_N = 4224;
static_assert(A_BT_OFF + (A_BT_N + 128) * 4 <= RING_BYTES, "attnA LDS");

__device__ __forceinline__ float xhalf_max(float v) {
    float a = v, b = v; asm volatile("s_nop 1\n\tv_permlane32_swap_b32_e32 %0, %1\n\ts_nop 1" : "+v"(a), "+v"(b));     return fmaxf(a, b);
}
__device__ __forceinline__ float xhalf_sum(float v) { float a = v, b = v; asm volatile("s_nop 1\n\tv_permlane32_swap_b32_e32 %0, %1\n\ts_nop 1" : "+v"(a), "+v"(b));     return a + b; }
#define SBAR0() __builtin_amdgcn_sched_barrier(0)
constexpr float A_THR = 24.f;

__device__ __forceinline__ void a_bias(const LAS float* bt, f32x16& p0, f32x16& p1) {
#pragma unroll
    for (int r = 0; r < 16; ++r) { p0[r] = bt[OFFR(r)]; p1[r] = bt[OFFR(r) + 32]; }
}
__device__ __forceinline__ void a_qk(const LAS char* ka, const bf16x8 (&qf)[4], f32x16& p0, f32x16& p1) {
    bf16x8 kf[2][2];
    kf[0][0] = *(const LAS bf16x8*)(ka); kf[0][1] = *(const LAS bf16x8*)(ka + 32 * A_KSTR);
    SBAR0();
#pragma unroll
    for (int s = 0; s < 4; ++s) {
        if (s < 3) { kf[(s + 1) & 1][0] = *(const LAS bf16x8*)(ka + (s + 1) * 32); kf[(s + 1) & 1][1] = *(const LAS bf16x8*)(ka + 32 * A_KSTR + (s + 1) * 32); }
        SBAR0();
        p0 = __builtin_amdgcn_mfma_f32_32x32x16_bf16(kf[s & 1][0], qf[s], p0, 0, 0, 0); p1 = __builtin_amdgcn_mfma_f32_32x32x16_bf16(kf[s & 1][1], qf[s], p1, 0, 0, 0);
        SBAR0();
    }
}
#define A_PIN(x) asm volatile("" : "+v"(x))
template <int I> __device__ __forceinline__ void a_dma_piece(const char* gb, LAS char* lds, size_t kg, size_t vg, int kb, int vb, int w, const unsigned (&dgo)[5]) {
    const size_t so = I < 2 ? kg : (I == 2 ? (w == 0 ? kg : vg) : vg);
    const int dp = I == 0 ? kb + w * 1024 : I == 1 ? kb + (w + 8) * 1024 : I == 2 ? (w == 0 ? kb + 16 * 1024 : vb + (w - 1) * 1024) : I == 3 ? vb + (w + 7) * 1024 : (w < 5 ? vb + (w + 15) * 1024 : vb + (w + 7) * 1024);
    __builtin_amdgcn_global_load_lds((const unsigned*)(gb + so + dgo[I]), (LAS unsigned*)(lds + dp), 16, 0, 0);
}
__device__ __forceinline__ void a_fused(const LAS char* ka, const bf16x8 (&qf)[4], f32x16& n0, f32x16& n1, f32x16& c0, f32x16& c1, const LAS char* va, const LAS float* bt2, float& lsum, f32x16 (&o)[4],
                                        const char* gb, LAS char* lds, size_t kg, size_t vg, int kb, int vb, int w, const unsigned (&dgo)[5]) {
    bf16x8 kf[2][2]; v4u pw[4]; s16x4 lo[3], hh[3];
#define A_KRD(s_) do { kf[(s_) & 1][0] = *(const LAS bf16x8*)(ka + (s_) * 32); kf[(s_) & 1][1] = *(const LAS bf16x8*)(ka + 32 * A_KSTR + (s_) * 32); } while (0)
#define A_VRD(j_) do { lo[(j_) % 3] = vtr(va + ((j_) >> 2) * 16 * A_VSTR + ((j_) & 3) * 64); hh[(j_) % 3] = vtr(va + ((j_) >> 2) * 16 * A_VSTR + 8 * A_VSTR + ((j_) & 3) * 64); } while (0)
#define A_SOFT(C, m_) do { const float e0 = __builtin_amdgcn_exp2f(C[(2 * (m_)) & 15]), e1 = __builtin_amdgcn_exp2f(C[(2 * (m_) + 1) & 15]); \
        sA += e0; sB += e1; pw[(m_) >> 2][(m_) & 3] = cvtpk_s(e0, e1); A_PIN(pw[(m_) >> 2]); A_PIN(sA); A_PIN(sB); } while (0)
    A_KRD(0);
    float sA = 0.f, sB = 0.f;
    SBAR0();
#pragma unroll
    for (int i = 0; i < 8; ++i) {
        const int st = i >> 1;
        if (!(i & 1) && i < 6) A_KRD(st + 1);
        if (i >= 6) A_VRD(i - 6);
        if (i == 0) a_dma_piece<0>(gb, lds, kg, vg, kb, vb, w, dgo); if (i == 1) a_dma_piece<1>(gb, lds, kg, vg, kb, vb, w, dgo); if (i == 2) a_dma_piece<2>(gb, lds, kg, vg, kb, vb, w, dgo); if (i == 3) a_dma_piece<3>(gb, lds, kg, vg, kb, vb, w, dgo); if (i == 4) a_dma_piece<4>(gb, lds, kg, vg, kb, vb, w, dgo);
        SBAR0();
        if (i & 1) n1 = __builtin_amdgcn_mfma_f32_32x32x16_bf16(kf[st & 1][1], qf[st], n1, 0, 0, 0); else n0 = __builtin_amdgcn_mfma_f32_32x32x16_bf16(kf[st & 1][0], qf[st], n0, 0, 0, 0);
        A_SOFT(c0, i);
        SBAR0();
    }
#pragma unroll
    for (int j = 0; j < 16; ++j) {
        if (j + 2 < 16) A_VRD(j + 2);
        if (j >= 8) {
#pragma unroll
            for (int q = 0; q < 2; ++q) { const int r = 2 * (j - 8) + q; c0[r] = bt2[OFFR(r)]; c1[r] = bt2[OFFR(r) + 32]; } }
        SBAR0();
        { const s16x4 a = lo[j % 3], bq_ = hh[j % 3]; const bf16x8 vf = {a[0], a[1], a[2], a[3], bq_[0], bq_[1], bq_[2], bq_[3]};
          o[j & 3] = __builtin_amdgcn_mfma_f32_32x32x16_bf16(vf, __builtin_bit_cast(bf16x8, pw[j >> 2]), o[j & 3], 0, 0, 0); }
        if (j < 8) A_SOFT(c1, 8 + j);
        SBAR0();
    }
    lsum += sA + sB;
#undef A_KRD
#undef A_VRD
#undef A_SOFT
}

constexpr int A_KB = 64 * A_KSTR, A_VB = 64 * A_VSTR, A_VOFF = 2 * A_KB;
static_assert(A_VOFF + 2 * A_VB == A_BT_OFF, "attnA LDS map");
template <int MODE> __device__ __forceinline__ void attnA_unit(LAS char* lds, int b, int h, int qblk, const bf16* Q, const bf16* K, const bf16* V, bf16* O, const float* bt_g, const float* ut_g, float shift, float lam, const float* subln, float oscale) {
    const int tid = tid_fresh(), w = __builtin_amdgcn_readfirstlane(tid >> 6), l = tid & 63, r32 = l & 31, hi = l >> 5;
    const int qt = w & 3, c = w >> 2;
    LAS float* btab = (LAS float*)(lds + A_BT_OFF);
    { const f32x4 t0 = *(const f32x4*)(bt_g + 4 * tid), t1 = *(const f32x4*)(bt_g + 4 * (tid + 512));
      f32x4 t2 = {0.f, 0.f, 0.f, 0.f}; if (tid < 32) t2 = *(const f32x4*)(bt_g + 4 * (tid + 1024));
      *(LAS f32x4*)(btab + 4 * tid) = t0 - shift; *(LAS f32x4*)(btab + 4 * (tid + 512)) = t1 - shift; if (tid < 32) *(LAS f32x4*)(btab + 4 * (tid + 1024)) = t2 - shift; }
    const int q0w = qblk * 128 + qt * 32;
    const int qpos = q0w + r32;
    const size_t rowq = (size_t)b * SEQ + qpos;
    bf16x8 qf[4];
#pragma unroll
    for (int s = 0; s < 4; ++s) qf[s] = *(const bf16x8*)(Q + rowq * 1024 + h * 128 + c * 64 + 16 * s + 8 * hi);
    f32x16 o[4];
#pragma unroll
    for (int dt = 0; dt < 4; ++dt)
#pragma unroll
        for (int r = 0; r < 16; ++r) o[dt][r] = 0.f;
    float lsum = 0.f;
    const int nkt = 2 * (qblk + 1);
    const int my_last = (q0w + 31) >> 6;
    const bf16* Kg = K + (size_t)b * SEQ * 1024 + h * 128; const bf16* Vg = V + (size_t)b * SEQ * 1024 + h * 128;
    const size_t vdelta = (size_t)((const char*)Vg - (const char*)Kg);
    const int row0 = tid >> 4, cc = tid & 15;
    unsigned dgo[5]; (void)row0; (void)cc;
#pragma unroll
    for (int i = 0; i < 5; ++i) { const int j = w + 8 * i; int row, col;
        if (j < 17) { const int P = 64 * j + l; row = P / 17; col = P - 17 * row; } else { const int P = 64 * (j - 17) + l; row = P / 20; col = P - 20 * row; }
        col = col > 15 ? 15 : col; row = row > 63 ? 63 : row;
        dgo[i] = (unsigned)(row * 1024 + col * 8) * 2u; }
    if (w >= 5) dgo[4] = dgo[3];
#define A_DMA(i, gsrc, ldst) __builtin_amdgcn_global_load_lds((const unsigned*)((const char*)(gsrc) + dgo[i]), (LAS unsigned*)(ldst), 16, 0, 0)
#define A_DMAK(kt, buf) do { const bf16* kp_ = Kg + (size_t)(kt) * 65536; LAS char* kb_ = lds + (buf) * A_KB; \
        A_DMA(0, kp_, kb_ + w * 1024); A_DMA(1, kp_, kb_ + (w + 8) * 1024); if (w == 0) A_DMA(2, kp_, kb_ + 16 * 1024); } while (0)
#define A_DMAV(kt, buf) do { const bf16* vp_ = Vg + (size_t)(kt) * 65536; LAS char* vb_ = lds + A_VOFF + (buf) * A_VB; \
        if (w != 0) A_DMA(2, vp_, vb_ + (w - 1) * 1024); A_DMA(3, vp_, vb_ + (w + 7) * 1024); if (w < 5) A_DMA(4, vp_, vb_ + (w + 15) * 1024); } while (0)
#define A_DMAWAIT() asm volatile("s_waitcnt vmcnt(0)" ::: "memory")
    A_DMAK(0, 0); A_DMAV(0, 0); A_DMAK(1, 1);
    A_DMAWAIT();
    __syncthreads();
    const int q_ = (l & 15) >> 2, p_ = l & 3, rhalf = (l >> 4) & 1;
    const int ka_off = r32 * A_KSTR + c * 128 + hi * 16;
    const int va_off = A_VOFF + (4 * hi + q_) * A_VSTR + (16 * rhalf + 4 * p_) * 2;
    f32x16 sa0, sa1, sb0, sb1;
    const LAS float* bt0 = btab + (4095 - qpos + 4 * hi);
    a_bias(bt0, sa0, sa1); a_bias(bt0 + 64, sb0, sb1);
    a_qk(lds + ka_off, qf, sa0, sa1);
    __syncthreads();
#define A_STEP(t, c0, c1, n0, n1) do { \
        const int tk_ = (t) + 2 < nkt ? (t) + 2 : nkt - 1, tv_ = (t) + 1 < nkt ? (t) + 1 : nkt - 1; \
        const size_t kg_ = (size_t)tk_ * 131072, vg_ = vdelta + (size_t)tv_ * 131072; const int kb_ = ((t) & 1) * A_KB, vb_ = A_VOFF + (((t) + 1) & 1) * A_VB; \
        if ((t) <= my_last)     \
            a_fused(lds + (((t) + 1) & 1) * A_KB + ka_off, qf, n0, n1, c0, c1, lds + ((t) & 1) * A_VB + va_off, bt0 + 64 * ((t) + 2), lsum, o, (const char*)Kg, lds, kg_, vg_, kb_, vb_, w, dgo); \
        A_DMAWAIT(); \
        __syncthreads(); } while (0)
    for (int kt = 0; kt < nkt; kt += 2) { A_STEP(kt, sa0, sa1, sb0, sb1); A_STEP(kt + 1, sb0, sb1, sa0, sa1); }
#undef A_STEP
#undef A_DMA
#undef A_DMAK
#undef A_DMAV
#undef A_DMAWAIT
    const float lt = xhalf_sum(lsum), inv = 1.f / lt;
    LAS float* xch = (LAS float*)lds;
    if (c == 1) {
#pragma unroll
        for (int dt = 0; dt < 4; ++dt)
#pragma unroll
            for (int r = 0; r < 16; ++r) xch[(qt * 64 + dt * 16 + r) * 64 + l] = o[dt][r] * inv;
    }
    __syncthreads();
    if (c == 0) {
        float ss = 0.f;
#pragma unroll
        for (int dt = 0; dt < 4; ++dt)
#pragma unroll
            for (int r = 0; r < 16; ++r) { const float v = o[dt][r] * inv - lam * xch[(qt * 64 + dt * 16 + r) * 64 + l]; o[dt][r] = v; ss += v * v; }
        ss = xhalf_sum(ss);
        const float rn = __builtin_amdgcn_rsqf(ss * (1.f / 128.f) + EPS) * oscale;
        LAS char* st = lds + 65536 + (qt * 32 + r32) * 272;
#pragma unroll
        for (int dt = 0; dt < 4; ++dt)
#pragma unroll
            for (int g4 = 0; g4 < 4; ++g4) { const int d0 = 32 * dt + 8 * g4 + 4 * hi; const f32x4 sg = *(const f32x4*)(subln + d0);
                v2u wv; wv.x = cvt_pk_bf16(o[dt][4 * g4 + 0] * rn * sg.x, o[dt][4 * g4 + 1] * rn * sg.y); wv.y = cvt_pk_bf16(o[dt][4 * g4 + 2] * rn * sg.z, o[dt][4 * g4 + 3] * rn * sg.w);
                *(LAS v2u*)(st + d0 * 2) = wv; }
    }
    __syncthreads();
#pragma unroll
    for (int k = 0; k < 4; ++k) { const int rr = (tid >> 4) + 32 * k, cq = tid & 15;
        const v4u v = *(const LAS v4u*)(lds + 65536 + rr * 272 + cq * 16);
        *(v4u*)(O + ((size_t)b * SEQ + qblk * 128 + rr) * 1024 + h * 128 + cq * 8) = v; }
    __syncthreads();
}

constexpr int C_KSTR = 256, C_VSTR = 256, C_KB = 64 * C_KSTR, C_VB = 64 * C_VSTR, C_VOFF = 2 * C_KB, C_BT_OFF = C_VOFF + 2 * C_VB;
constexpr int C_ST_OFF = C_BT_OFF + A_BT_N * 4;
static_assert(C_BT_OFF >= 65536 && C_ST_OFF + 128 * 272 <= RING_BYTES, "attnA16 LDS");
#define C_MFMA(a, b, c) __builtin_amdgcn_mfma_f32_16x16x32_bf16(a, b, c, 0, 0, 0)
__device__ __forceinline__ void c_bias(const LAS float* bt, f32x4 (&p)[4][2]) {
#pragma unroll
    for (int kt = 0; kt < 4; ++kt)
#pragma unroll
        for (int n = 0; n < 2; ++n)
#pragma unroll
            for (int e = 0; e < 4; ++e) p[kt][n][e] = bt[16 * kt + 16 * (1 - n) + e];
}
__device__ __forceinline__ void c_qk(const LAS char* ka0, const LAS char* ka1, const bf16x8 (&qf)[2][2], f32x4 (&p)[4][2]) {
#pragma unroll
    for (int s = 0; s < 2; ++s)
#pragma unroll
        for (int kt = 0; kt < 4; ++kt) { const bf16x8 kf = *(const LAS bf16x8*)((s ? ka1 : ka0) + kt * 16 * C_KSTR);
            p[kt][0] = C_MFMA(kf, qf[0][s], p[kt][0]); p[kt][1] = C_MFMA(kf, qf[1][s], p[kt][1]); }
}
template <int I> __device__ __forceinline__ void c_dma_piece(const char* gb, LAS char* lds, size_t kg, size_t vg, int kb, int vb, int w, const unsigned (&dgo)[4]) {
    const size_t so = I < 2 ? kg : vg;
    const int dp = (I < 2 ? kb : vb) + (w + 8 * (I & 1)) * 1024;
    __builtin_amdgcn_global_load_lds((const unsigned*)(gb + so + dgo[I]), (LAS unsigned*)(lds + dp), 16, 0, 0);
}
__device__ __forceinline__ void c_fused(const LAS char* ka0, const LAS char* ka1, const bf16x8 (&qf)[2][2], f32x4 (&n)[4][2], f32x4 (&c)[4][2], const LAS char* vb_l, const int (&vam)[8], const LAS float* bt2, float (&lsum)[2], f32x4 (&o)[8][2],
                                        const char* gb, LAS char* lds, size_t kg, size_t vg, int kb, int vb, int w, const unsigned (&dgo)[4]) {
    bf16x8 kf[2]; v4u pw[2][2]; s16x4 lo[3], hh[3]; float s0 = 0.f, s1 = 0.f, ev = 0.f;
#define C_KRD(f_) (*(const LAS bf16x8*)((((f_) >> 2) ? ka1 : ka0) + ((f_) & 3) * 16 * C_KSTR))
#define C_VRD(f_) do { lo[(f_) % 3] = vtr(vb_l + vam[(f_) & 7] + ((f_) >> 3) * 32 * C_VSTR); hh[(f_) % 3] = vtr(vb_l + vam[(f_) & 7] + ((f_) >> 3) * 32 * C_VSTR + 16 * C_VSTR); } while (0)
#define C_SOFT(KS, v_) do { const float x_ = __builtin_amdgcn_exp2f(c[2 * (KS) + ((v_) >> 3)][((v_) >> 2) & 1][(v_) & 3]); if (((v_) >> 2) & 1) s1 += x_; else s0 += x_; \
        if ((v_) & 1) { pw[KS][((v_) >> 2) & 1][2 * ((v_) >> 3) + (((v_) & 3) >> 1)] = cvtpk_s(ev, x_); A_PIN(pw[KS][((v_) >> 2) & 1]); } else { ev = x_; A_PIN(ev); } A_PIN(s0); A_PIN(s1); } while (0)
    c_dma_piece<0>(gb, lds, kg, vg, kb, vb, w, dgo); c_dma_piece<1>(gb, lds, kg, vg, kb, vb, w, dgo); c_dma_piece<2>(gb, lds, kg, vg, kb, vb, w, dgo); c_dma_piece<3>(gb, lds, kg, vg, kb, vb, w, dgo);
    kf[0] = C_KRD(0);
    SBAR0();
#pragma unroll
    for (int i = 0; i < 16; ++i) {
        const int f = i >> 1;
        if (!(i & 1) && f + 1 < 8) kf[(f + 1) & 1] = C_KRD(f + 1);
        if (i == 12) C_VRD(0); if (i == 14) C_VRD(1);

        SBAR0();
        n[f & 3][i & 1] = C_MFMA(kf[f & 1], qf[i & 1][f >> 2], n[f & 3][i & 1]);
        C_SOFT(0, i);
        SBAR0();
    }
#pragma unroll
    for (int jj = 0; jj < 32; ++jj) {
        const int f = jj >> 1;
        if (!(jj & 1) && f + 2 < 16) C_VRD(f + 2);
        if (jj >= 16) {
#pragma unroll
            for (int q = 0; q < 2; ++q) { const int r = 2 * (jj - 16) + q; c[r >> 3][(r >> 2) & 1][r & 3] = bt2[16 * (r >> 3) + 16 * (1 - ((r >> 2) & 1)) + (r & 3)]; } }
        SBAR0();
        { const s16x4 a = lo[f % 3], b_ = hh[f % 3]; const bf16x8 vf = {a[0], a[1], a[2], a[3], b_[0], b_[1], b_[2], b_[3]};
          o[f & 7][jj & 1] = C_MFMA(vf, __builtin_bit_cast(bf16x8, pw[f >> 3][jj & 1]), o[f & 7][jj & 1]); }
        if (jj < 16) C_SOFT(1, jj);
        SBAR0();
    }
    lsum[0] += s0; lsum[1] += s1;
#undef C_KRD
#undef C_VRD
#undef C_SOFT
}
__device__ __forceinline__ void attnA16_unit(LAS char* lds, int b, int h, int qblk, const bf16* Q, const bf16* K, const bf16* V, bf16* O, const float* bt_g, bool load_table, float shift, float lam, const float* subln, float oscale) {
    const int tid = tid_fresh(), w = __builtin_amdgcn_readfirstlane(tid >> 6), l = tid & 63, j = l & 15, g = l >> 4;
    const int qt = w & 3, c = w >> 2;
    LAS float* btab = (LAS float*)(lds + C_BT_OFF);
    if (load_table) {
      const f32x4 t0 = *(const f32x4*)(bt_g + 4 * tid), t1 = *(const f32x4*)(bt_g + 4 * (tid + 512));
      f32x4 t2 = {0.f, 0.f, 0.f, 0.f}; if (tid < 32) t2 = *(const f32x4*)(bt_g + 4 * (tid + 1024));
      *(LAS f32x4*)(btab + 4 * tid) = t0 - shift; *(LAS f32x4*)(btab + 4 * (tid + 512)) = t1 - shift; if (tid < 32) *(LAS f32x4*)(btab + 4 * (tid + 1024)) = t2 - shift; }
    const int q0w = qblk * 128 + qt * 32;
    bf16x8 qf[2][2];
#pragma unroll
    for (int n = 0; n < 2; ++n)
#pragma unroll
        for (int s = 0; s < 2; ++s) qf[n][s] = *(const bf16x8*)(Q + ((size_t)b * SEQ + q0w + 16 * n + j) * 1024 + h * 128 + c * 64 + 32 * s + 8 * g);
    f32x4 o[8][2];
#pragma unroll
    for (int m = 0; m < 8; ++m)
#pragma unroll
        for (int n = 0; n < 2; ++n) o[m][n] = (f32x4){0.f, 0.f, 0.f, 0.f};
    float lsum[2] = {0.f, 0.f};
    const int nkt = 2 * (qblk + 1);
    const int my_last = (q0w + 31) >> 6;
    const bf16* Kg = K + (size_t)b * SEQ * 1024 + h * 128; const bf16* Vg = V + (size_t)b * SEQ * 1024 + h * 128;
    const size_t vdelta = (size_t)((const char*)Vg - (const char*)Kg);
    unsigned dgo[4];
#pragma unroll
    for (int i = 0; i < 4; ++i) { const int blk = w + 8 * (i & 1), row = 4 * blk + (l >> 4), pos = l & 15, ch = i < 2 ? (pos ^ (row & 15)) : (pos ^ (2 * (row & 7)));
        dgo[i] = (unsigned)(row * 1024 + ch * 8) * 2u; }
    {
        const char* gb = (const char*)Kg;
        c_dma_piece<0>(gb, lds, 0, vdelta, 0, C_VOFF, w, dgo); c_dma_piece<1>(gb, lds, 0, vdelta, 0, C_VOFF, w, dgo); c_dma_piece<2>(gb, lds, 0, vdelta, 0, C_VOFF, w, dgo); c_dma_piece<3>(gb, lds, 0, vdelta, 0, C_VOFF, w, dgo);
        c_dma_piece<0>(gb, lds, 131072, vdelta, C_KB, C_VOFF, w, dgo); c_dma_piece<1>(gb, lds, 131072, vdelta, C_KB, C_VOFF, w, dgo);
    }
    asm volatile("s_waitcnt vmcnt(0)" ::: "memory");
    __syncthreads();
    const int ka_off0 = j * C_KSTR + (((8 * c + g) ^ j) << 4), ka_off1 = j * C_KSTR + ((((8 * c + g) ^ j) ^ 4) << 4);
    int vam[8];
    { const int q4 = (l & 15) >> 2, p4 = l & 3, rw = 4 * g + q4;
#pragma unroll
      for (int m = 0; m < 8; ++m) vam[m] = C_VOFF + rw * C_VSTR + ((((2 * m) ^ (2 * (rw & 7))) + (p4 >> 1)) << 4) + (p4 & 1) * 8; }
    f32x4 sa[4][2], sb[4][2];
    const LAS float* bt0 = btab + (4095 - q0w - j + 4 * g - 16);
    c_bias(bt0, sa); c_bias(bt0 + 64, sb);
    c_qk(lds + ka_off0, lds + ka_off1, qf, sa);
    __syncthreads();
#define C_STEP(t, cc, nn) do { \
        const int tk_ = (t) + 2 < nkt ? (t) + 2 : nkt - 1, tv_ = (t) + 1 < nkt ? (t) + 1 : nkt - 1; \
        const size_t kg_ = (size_t)tk_ * 131072, vg_ = vdelta + (size_t)tv_ * 131072; const int kb_ = ((t) & 1) * C_KB, vb_ = C_VOFF + (((t) + 1) & 1) * C_VB; \
        if ((t) <= my_last)     \
            c_fused(lds + (((t) + 1) & 1) * C_KB + ka_off0, lds + (((t) + 1) & 1) * C_KB + ka_off1, qf, nn, cc, lds + ((t) & 1) * C_VB, vam, bt0 + 64 * ((t) + 2), lsum, o, (const char*)Kg, lds, kg_, vg_, kb_, vb_, w, dgo); \
        asm volatile("s_waitcnt vmcnt(0)" ::: "memory"); \
        __syncthreads(); } while (0)
    for (int kt = 0; kt < nkt; kt += 2) { C_STEP(kt, sa, sb); C_STEP(kt + 1, sb, sa); }
#undef C_STEP
    float inv[2];
#pragma unroll
    for (int n = 0; n < 2; ++n) inv[n] = 1.f / quad16_sum(lsum[n]);
    LAS float* xch = (LAS float*)lds;
    if (c == 1) {
#pragma unroll
        for (int m = 0; m < 8; ++m)
#pragma unroll
            for (int n = 0; n < 2; ++n)
#pragma unroll
                for (int e = 0; e < 4; ++e) xch[(qt * 64 + (m * 2 + n) * 4 + e) * 64 + l] = o[m][n][e] * inv[n];
    }
    __syncthreads();
    if (c == 0) {
        float ss[2] = {0.f, 0.f};
#pragma unroll
        for (int m = 0; m < 8; ++m)
#pragma unroll
            for (int n = 0; n < 2; ++n)
#pragma unroll
                for (int e = 0; e < 4; ++e) { const float v = o[m][n][e] * inv[n] - lam * xch[(qt * 64 + (m * 2 + n) * 4 + e) * 64 + l]; o[m][n][e] = v; ss[n] += v * v; }
#pragma unroll
        for (int n = 0; n < 2; ++n) { const float rn = __builtin_amdgcn_rsqf(quad16_sum(ss[n]) * (1.f / 128.f) + EPS) * oscale;
            LAS char* st = lds + C_ST_OFF + (qt * 32 + 16 * n + j) * 272;
#pragma unroll
            for (int m = 0; m < 8; ++m) { const int d0 = 16 * m + 4 * g; const f32x4 sg = *(const f32x4*)(subln + d0);
                v2u wv; wv.x = cvt_pk_bf16(o[m][n][0] * rn * sg.x, o[m][n][1] * rn * sg.y); wv.y = cvt_pk_bf16(o[m][n][2] * rn * sg.z, o[m][n][3] * rn * sg.w);
                *(LAS v2u*)(st + d0 * 2) = wv; } }
    }
    __syncthreads();
#pragma unroll
    for (int k = 0; k < 4; ++k) { const int rr = (tid >> 4) + 32 * k, cq = tid & 15;
        const v4u v = *(const LAS v4u*)(lds + C_ST_OFF + rr * 272 + cq * 16);
        *(v4u*)(O + ((size_t)b * SEQ + qblk * 128 + rr) * 1024 + h * 128 + cq * 8) = v; }
    __syncthreads();
}

constexpr int B_KSTR = 144, B_VSTR = 192, B_ROWS = 384, B_V_OFF = B_ROWS * B_KSTR, B_BT_OFF = B_V_OFF + B_ROWS * B_VSTR, B_BT_N = 224;
static_assert(B_BT_OFF + B_BT_N * 4 <= RING_BYTES, "attnB LDS");

template <bool HALF_T>
__device__ __forceinline__ void b_qk(const LAS char* ka, const bf16x8 (&qf)[4], f32x16& p0, f32x16& p1) {
    bf16x8 kf[2][2];
#pragma unroll
    for (int r = 0; r < 16; ++r) { p0[r] = 0.f; p1[r] = 0.f; }
    kf[0][0] = *(const LAS bf16x8*)(ka); if (!HALF_T) kf[0][1] = *(const LAS bf16x8*)(ka + 32 * B_KSTR);
    SBAR0();
#pragma unroll
    for (int s = 0; s < 4; ++s) {
        if (s < 3) { kf[(s + 1) & 1][0] = *(const LAS bf16x8*)(ka + (s + 1) * 32); if (!HALF_T) kf[(s + 1) & 1][1] = *(const LAS bf16x8*)(ka + 32 * B_KSTR + (s + 1) * 32); }
        SBAR0();
        p0 = __builtin_amdgcn_mfma_f32_32x32x16_bf16(kf[s & 1][0], qf[s], p0, 0, 0, 0); if (!HALF_T) p1 = __builtin_amdgcn_mfma_f32_32x32x16_bf16(kf[s & 1][1], qf[s], p1, 0, 0, 0);
        SBAR0();
    }
}
template <bool HALF_T>
__device__ __forceinline__ void b_softmax_pv(f32x16& p0, f32x16& p1, const LAS char* va, const LAS float* bt, int kbase_sp, int hi, float shift, float& lsum, f32x16 (&o)[2]) {
    { float bv[16];
#pragma unroll
      for (int r = 0; r < 16; ++r) bv[r] = bt[OFFR(r)];
      SBAR0();
#pragma unroll
      for (int r = 0; r < 16; ++r) p0[r] += bv[r] - shift;
      if (!HALF_T) { SBAR0();
#pragma unroll
          for (int r = 0; r < 16; ++r) bv[r] = bt[OFFR(r) + 32];
          SBAR0();
#pragma unroll
          for (int r = 0; r < 16; ++r) p1[r] += bv[r] - shift; } }
    if (kbase_sp < 0) {
#pragma unroll
        for (int r = 0; r < 16; ++r) { if (kbase_sp + 4 * hi + OFFR(r) < 0) p0[r] = -INFINITY; if (!HALF_T) { if (kbase_sp + 4 * hi + OFFR(r) + 32 < 0) p1[r] = -INFINITY; } }
    }
    float ps = 0.f;
#pragma unroll
    for (int r = 0; r < 16; ++r) { p0[r] = __builtin_amdgcn_exp2f(p0[r]); ps += p0[r]; if (!HALF_T) { p1[r] = __builtin_amdgcn_exp2f(p1[r]); ps += p1[r]; } }
    lsum += ps;
    bf16x8 pb[4]; pb[0] = pack8(p0, 0); pb[1] = pack8(p0, 1); if (!HALF_T) { pb[2] = pack8(p1, 0); pb[3] = pack8(p1, 1); }
    constexpr int NG = HALF_T ? 2 : 4;
    s16x4 lo[2][2], hh[2][2];
#pragma unroll
    for (int dt = 0; dt < 2; ++dt) { lo[0][dt] = vtr(va + dt * 64); hh[0][dt] = vtr(va + 8 * B_VSTR + dt * 64); }
    SBAR0();
#pragma unroll
    for (int s = 0; s < NG; ++s) {
        if (s < NG - 1) {
#pragma unroll
            for (int dt = 0; dt < 2; ++dt) { lo[(s + 1) & 1][dt] = vtr(va + (s + 1) * 16 * B_VSTR + dt * 64); hh[(s + 1) & 1][dt] = vtr(va + (s + 1) * 16 * B_VSTR + 8 * B_VSTR + dt * 64); }
        }
        SBAR0();
#pragma unroll
        for (int dt = 0; dt < 2; ++dt) { const s16x4 a = lo[s & 1][dt], bq = hh[s & 1][dt]; const bf16x8 vf = {a[0], a[1], a[2], a[3], bq[0], bq[1], bq[2], bq[3]};
            o[dt] = __builtin_amdgcn_mfma_f32_32x32x16_bf16(vf, pb[s], o[dt], 0, 0, 0); }
        SBAR0();
    }
}

struct BUnit { int g, dil, b, res, h, nn; };
__device__ __forceinline__ BUnit b_decode(int u) {
    BUnit x; x.g = u >> 9; const int idx = u & 511; x.dil = x.g == 0 ? 1 : (x.g == 1 ? 4 : 16); const int nper = 16 / x.dil;
    x.nn = idx % nper; const int rest = idx / nper; x.h = rest & 7; const int bp = rest >> 3; x.b = bp / x.dil; x.res = bp - x.b * x.dil; return x;
}
__device__ __forceinline__ size_t b_hbase(const BUnit& x) { return ((size_t)(((x.g * 8 + x.h) * 4 + x.b) * 4096 + x.res * (4096 / x.dil))) * 64; }

__device__ __forceinline__ void attnB_phase(LAS char* lds, int vcu, int G, const bf16* QB, const bf16* KS, const bf16* VS, bf16* OG, float* LSE, const float* biasb, const float* shifts) {
    const int tid = tid_fresh(), w = __builtin_amdgcn_readfirstlane(tid >> 6), l = tid & 63, r32 = l & 31, hi = l >> 5;
    const int q_ = (l & 15) >> 2, p_ = l & 3, rhalf = (l >> 4) & 1;
    LAS float* btab = (LAS float*)(lds + B_BT_OFF);
    v4u kv[6], vv[6]; bf16x8 qn[4]; float btv = 0.f;
#define B_PREFETCH(X) do { const size_t hb_ = b_hbase(X); \
        _Pragma("unroll") for (int it = 0; it < 6; ++it) { const int ch = tid + 512 * it, i = ch >> 3, c8 = ch & 7, sp = 256 * (X).nn - 128 + i, spc = sp < 0 ? 0 : sp; \
            const size_t go = hb_ + (size_t)spc * 64 + c8 * 8; kv[it] = *(const v4u*)(KS + go); vv[it] = *(const v4u*)(VS + go); } \
        _Pragma("unroll") for (int s = 0; s < 4; ++s) qn[s] = *(const bf16x8*)(QB + hb_ + (size_t)(256 * (X).nn + 32 * w + r32) * 64 + 16 * s + 8 * hi); \
        if (tid < B_BT_N) btv = biasb[((X).g * 8 + (X).h) * 224 + tid]; } while (0)
    int u = vcu;
    if (u >= 1536) return;
    BUnit cur = b_decode(u);
    B_PREFETCH(cur);
#pragma unroll 1
    for (;;) {
#pragma unroll
        for (int it = 0; it < 6; ++it) { const int ch = tid + 512 * it, i = ch >> 3, c8 = ch & 7, sp = 256 * cur.nn - 128 + i;
            const v4u z = {0u, 0u, 0u, 0u};
            *(LAS v4u*)(lds + i * B_KSTR + c8 * 16) = sp < 0 ? z : kv[it]; *(LAS v4u*)(lds + B_V_OFF + i * B_VSTR + c8 * 16) = sp < 0 ? z : vv[it]; }
        if (tid < B_BT_N) btab[tid] = btv;
        bf16x8 qf[4];
#pragma unroll
        for (int s = 0; s < 4; ++s) qf[s] = qn[s];
        __syncthreads();
        const int un = u + G; const bool has_next = un < 1536;
        BUnit nxt = cur; if (has_next) { nxt = b_decode(un); B_PREFETCH(nxt); }
        const float shift = shifts[cur.g];
        f32x16 o[2];
#pragma unroll
        for (int dt = 0; dt < 2; ++dt)
#pragma unroll
            for (int r = 0; r < 16; ++r) o[dt][r] = 0.f;
        float lsum = 0.f;
        const int i00 = 32 * w, kb0 = 256 * cur.nn - 128 + i00;
        const bool v0 = kb0 + 63 >= 0, v1 = kb0 + 127 >= 0;
        const LAS char* ka = lds + (i00 + r32) * B_KSTR + hi * 16;
        const LAS char* va = lds + B_V_OFF + (i00 + 4 * hi + q_) * B_VSTR + (16 * rhalf + 4 * p_) * 2;
        const LAS float* bt = btab + (31 - r32 + 4 * hi);
        f32x16 s00, s01, s10, s11, s20, s21;
        if (v0) b_qk<false>(ka, qf, s00, s01);
        if (v1) b_qk<false>(ka + 64 * B_KSTR, qf, s10, s11);
        b_qk<true>(ka + 128 * B_KSTR, qf, s20, s21);
        SBAR0();
        if (v0) b_softmax_pv<false>(s00, s01, va, bt, kb0, hi, shift, lsum, o);
        if (v1) b_softmax_pv<false>(s10, s11, va + 64 * B_VSTR, bt + 64, kb0 + 64, hi, shift, lsum, o);
        b_softmax_pv<true>(s20, s21, va + 128 * B_VSTR, bt + 128, kb0 + 128, hi, shift, lsum, o);
        const float lt = xhalf_sum(lsum), inv = 1.f / lt;
        bf16* OGg = OG + (size_t)cur.g * T * 512; float* LSEg = LSE + (size_t)cur.g * T * 8;
        const size_t tq = (size_t)cur.b * SEQ + (size_t)(256 * cur.nn + 32 * w + r32) * cur.dil + cur.res;
        if (hi == 0) LSEg[tq * 8 + cur.h] = shift + __builtin_amdgcn_logf(lt);
        __syncthreads();
        LAS char* st = lds + w * 4608;
#pragma unroll
        for (int dt = 0; dt < 2; ++dt)
#pragma unroll
            for (int g4 = 0; g4 < 4; ++g4) { const int d0 = 32 * dt + 8 * g4 + 4 * hi;
                v2u wv; wv.x = cvt_pk_bf16(o[dt][4 * g4 + 0] * inv, o[dt][4 * g4 + 1] * inv); wv.y = cvt_pk_bf16(o[dt][4 * g4 + 2] * inv, o[dt][4 * g4 + 3] * inv);
                *(LAS v2u*)(st + r32 * 144 + d0 * 2) = wv; }
#pragma unroll
        for (int k = 0; k < 4; ++k) { const int rr = (l >> 3) + 8 * k, cq = l & 7;
            const v4u v = *(const LAS v4u*)(st + rr * 144 + cq * 16);
            const size_t tr = (size_t)cur.b * SEQ + (size_t)(256 * cur.nn + 32 * w + rr) * cur.dil + cur.res;
            *(v4u*)(OGg + tr * 512 + cur.h * 64 + cq * 8) = v; }
        __syncthreads();
        if (!has_next) break;
        cur = nxt; u = un;
    }
#undef B_PREFETCH
}
}

struct Args { Inputs in; float* out; unsigned char* ws; int ph_lo, ph_hi, probe, pad; };
constexpr int N_PHASES = 32;
#ifndef SITE_MASK
#define SITE_MASK 0xFFFFFFFFu
#endif
#define SITE(id) (((SITE_MASK) >> (id)) & 1u)

typedef const Args __attribute__((address_space(4))) CArgs;
__device__ __forceinline__ CArgs* kargs() { CArgs* p = (CArgs*)__builtin_amdgcn_kernarg_segment_ptr(); asm volatile("" : "+s"(p)); return p; }

__global__ void __launch_bounds__(512, 2) fwd_kernel(Args args) {
    extern __shared__ __attribute__((aligned(16))) unsigned char lds_raw[];
    Frame F;
    F.lds = (LAS unsigned char*)lds_raw;
    F.tid = threadIdx.x; F.lane = F.tid & 63; F.wave = __builtin_amdgcn_readfirstlane(F.tid >> 6);
    F.G = gridDim.x; { const int bx = blockIdx.x; F.vcu = (F.G % 8 == 0) ? (bx % 8) * (F.G / 8) + bx / 8 : bx; }
    F.ws = args.ws;
    for (int u = F.tid; u < 64; u += 512) ((LAS unsigned*)(F.lds + LDSCTL_OFF))[u] = 0u;
    __syncthreads();
    const int lo = args.ph_lo, hi = args.ph_hi;
    const bool one_launch = (hi - lo) > 1;
    XcdBarrier bar; bar.bar = (unsigned*)(args.ws + WS_CTL) + CW_BAR; bar.x = 0; bar.st = nullptr;
    if (one_launch) bar = xcd_barrier_post((unsigned*)(args.ws + WS_CTL) + CW_BAR, (volatile LAS unsigned*)(F.lds + MISC_OFF) + 8);
#ifdef PROBE_R_MODE
#define RPMODE (PR ? PROBE_R_MODE : 0)
#else
#define RPMODE 0
#endif
#define IN(k) (lo <= (k) && (k) < hi)
#define SEAM(k) do { if (IN(k) && IN((k) + 1)) xcd_barrier(bar); } while (0)
#define ENTER() CArgs* ap = kargs(); const Inputs __attribute__((address_space(4)))& I = ap->in; F.ws = ap->ws; F.tid = tid_fresh(); F.lane = F.tid & 63; F.wave = __builtin_amdgcn_readfirstlane(F.tid >> 6); \
    bf16* X = (bf16*)(F.ws + WS_X); float* OUT = ap->out; (void)OUT; const float* MOD = (const float*)(F.ws + WS_MOD); bf16* HN = (bf16*)(F.ws + WS_HN); bf16* YB = (bf16*)(F.ws + WS_YB); bf16* ACT = (bf16*)(F.ws + WS_ACT); \
    int* ROWTOK = (int*)(F.ws + WS_ROWTOK); float* ROWW = (float*)(F.ws + WS_ROWW); gu32* CTL = (gu32*)(F.ws + WS_CTL); const bool PR = ap->probe != 0; bf16* Xo = PR ? (bf16*)(F.ws + WS_PROBE) : X; bf16* HNo = PR ? (bf16*)(F.ws + WS_PROBE + 64 * MiB) : HN; (void)Xo; (void)HNo; (void)X; (void)MOD; (void)HN; (void)YB; (void)ACT; (void)ROWTOK; (void)ROWW; (void)CTL; (void)I

    if (SITE(0) && IN(0)) { ENTER(); p0_prologue(F, I); } SEAM(0);

#pragma unroll 1
    for (int L = 0; L < 2; ++L) {
        const int pb = 1 + 7 * L;
#define mod (MOD + L * 4 * 6144)
        if (SITE(1) && IN(pb + 0)) { ENTER();
            if (L == 0) norm_phase<true>(F, I.p[0], nullptr, nullptr, nullptr, I.p[5], mod, mod + 1024, 6144, HNo, nullptr, nullptr, nullptr, 0, nullptr);
            else norm_phase<false>(F, X, Xo, YB, MOD + (L - 1) * 4 * 6144 + 5120, I.p[5] + L * D, mod, mod + 1024, 6144, HNo, nullptr, nullptr, nullptr, 0, nullptr);
        } SEAM(pb + 0);
        if (SITE(2) && IN(pb + 1)) { ENTER();
            pg8::Gemm g{HN, (const bf16*)(F.ws + WS_WQKVA) + (size_t)L * 3072 * 1024, T, 3072, D}; pg8::StaticOrder S; S.init(T, 3072, F.G, (int)blockIdx.x);
            EpiHN E{(bf16*)(F.ws + WS_QA), (WS_KA - WS_QA) / 2, I.p[8] + L * 64, (long)(I.p[9] - I.p[8]), 2, QSCALE, 4, 1024, 30, 0};
#ifdef PROBE_EPI_MODE
            E.pskip = PR ? PROBE_EPI_MODE : 0;
#endif
            pg8::gemm_phase<EpiHN, pg8::StaticOrder>(F.lds, g, S, E);
        } SEAM(pb + 1);
        if (SITE(3) && IN(pb + 2)) { ENTER();
            const float lam = ((const float*)(F.ws + WS_LAM))[L], shiftA = ((const float*)(F.ws + WS_LAM))[2 + L];
            const float lam_init = L == 0 ? 0.2f : 0.35550906759096906f;
#pragma unroll 1
            for (int pi2 = 2 * F.vcu; pi2 < 1024; pi2 += (pi2 & 1) ? 2 * F.G - 1 : 1) { const int pi = pi2 >> 1, bh = pi >> 4, j = pi & 15, b = bh >> 3, h = bh & 7;
#if MK_N_LAUNCHES == 0 && defined(PROBE_ATT_MODE)
                if (PR) att::attnA_unit<PROBE_ATT_MODE>((LAS char*)F.lds, b, h, (pi2 & 1) ? 31 - j : j, (const bf16*)(F.ws + WS_QA), (const bf16*)(F.ws + WS_KA), (const bf16*)(F.ws + WS_VA), (bf16*)(F.ws + WS_PROBE), (const float*)(F.ws + WS_BIASA) + h * 4224, (const float*)(F.ws + WS_UTAB) + h * 128, shiftA, lam, I.p[11] + L * 128, 1.f - lam_init); else
#endif
                att::attnA16_unit((LAS char*)F.lds, b, h, (pi2 & 1) ? 31 - j : j, (const bf16*)(F.ws + WS_QA), (const bf16*)(F.ws + WS_KA), (const bf16*)(F.ws + WS_VA), PR ? (bf16*)(F.ws + WS_PROBE) : (bf16*)(F.ws + WS_OA), (const float*)(F.ws + WS_BIASA) + h * 4224, true, shiftA, lam, I.p[11] + L * 128, 1.f - lam_init);
                if (!PR) {
                    LAS float* scr = (LAS float*)(F.lds + F.wave * 16640);
                    const int un_ = (pi2 - 2 * F.vcu) > 1 ? 2 + ((pi2 - 2 * F.vcu) & 1) : (pi2 - 2 * F.vcu);
                    if (un_ < 3) {
#pragma unroll 1
                        for (int q = 0; q < 2; ++q) moe_item64(F.ws, I.p[25], I.p[26], I.p[27], L, (un_ * 2 + q) * 2048 + F.vcu * 8 + F.wave, scr, F.lane);
                        __syncthreads(); } } }
        } SEAM(pb + 2);
        if (SITE(4) && IN(pb + 3)) { ENTER();
            pg8::Gemm g{(const bf16*)(F.ws + WS_OA), (const bf16*)(F.ws + WS_WOA) + (size_t)L * 1024 * 1024, T, D, D}; pg8::StaticOrder S; S.init(T, D, F.G, (int)blockIdx.x);
            gu32* xc = CTL + CW_XP + (PR ? 4 + L : L) * 1024;
            if (L == 0) { EpiResid<true> E{I.p[0], Xo, mod + 2048, xc}; pg8::gemm_phase<EpiResid<true>, pg8::StaticOrder>(F.lds, g, S, E); }
            else { EpiResid<false> E{X, Xo, mod + 2048, xc}; pg8::gemm_phase<EpiResid<false>, pg8::StaticOrder>(F.lds, g, S, E); }
        }
        if (SITE(5) && IN(pb + 4)) { ENTER();
            const int rowblk = F.vcu;
            router_phase(F, X, rowblk, ((ap->ph_hi - ap->ph_lo) > 1 && !PR) ? CTL + CW_XP + L * 1024 : nullptr, CTL + CW_TMO, I.p[6] + L * D, mod + 3072, mod + 4096, HNo, (const float*)(F.ws + WS_RWT) + (size_t)L * 36 * 1024, I.p[22] + L * 4, I.p[24] + L * 32, CTL + CW_GCNT + 2048 * (PR ? 4 + L : L), PR ? (int*)(F.ws + WS_PROBE + 96 * MiB) : ROWTOK, PR ? (float*)(F.ws + WS_PROBE + 100 * MiB) : ROWW, RPMODE);
        } SEAM(pb + 4);
        if (SITE(6) && IN(pb + 5)) { ENTER();
            moe_tables(F, CTL + CW_GCNT + 2048 * L, ROWTOK, ROWW);
            pg8::Gemm g{HN, (const bf16*)(F.ws + WS_MGU) + (size_t)L * 32 * 1024 * 1024, 0, 1024, D};
            MoeOrderG S; S.ul = (const LAS int*)(F.lds + ULIST_OFF); S.tokl = (const LAS int*)(F.lds + TOKL_OFF); S.K2 = 2048; S.cnt = nullptr; S.tmo = nullptr;
            EpiMoeGU E{ACT, CTL + CW_ACT + (PR ? 4 + L : L) * 2560};
            pg8::gemm_phase<EpiMoeGU, MoeOrderG>(F.lds, g, S, E);
        }
        if (SITE(7) && IN(pb + 6)) { ENTER();
            if (!one_launch) moe_tables(F, CTL + CW_GCNT + 2048 * L, ROWTOK, ROWW);
            pg8::Gemm g{ACT, (const bf16*)(F.ws + WS_MDN) + (size_t)L * 32 * 1024 * 512, 0, 1024, 512};
            MoeOrderC S; S.ul = (const LAS int*)(F.lds + ULIST_OFF) + 32; S.tokl = (const LAS int*)(F.lds + TOKL2_OFF); S.K2 = 1024; S.cnt = CTL + CW_ACT + L * 2560; S.tmo = CTL + CW_TMO;
            EpiMoeDown E{YB, (const LAS int*)(F.lds + TOKL2_OFF), (const LAS float*)(F.lds + WL_OFF)};
            pg8::gemm_phase<EpiMoeDown, MoeOrderC>(F.lds, g, S, E);
        } SEAM(pb + 6);
    }

#pragma unroll 1
    for (int J = 0; J < 2; ++J) {
        const int L = 2 + J, pb = 15 + 8 * J;
#define kvmod ((const float*)(F.ws + WS_KVMOD))
        if (SITE(8) && IN(pb + 0)) { ENTER();
            if (J == 0) norm_phase<false>(F, X, Xo, YB, MOD + (L - 1) * 4 * 6144 + 5120, I.p[5] + L * D, mod, mod + 1024, 6144, HNo, I.p[13], kvmod, kvmod + 1024, 2048, PR ? (bf16*)(F.ws + WS_PROBE + 104 * MiB) : (bf16*)(F.ws + WS_HKV));
            else norm_phase<false>(F, X, Xo, YB, MOD + (L - 1) * 4 * 6144 + 5120, I.p[5] + L * D, mod, mod + 1024, 6144, HNo, nullptr, nullptr, nullptr, 0, nullptr);
        } SEAM(pb + 0);
        if (SITE(9) && IN(pb + 1)) { ENTER();
            const int xcd_ = F.vcu >> 5, rk_ = F.vcu & 31, hr_ = J == 0 ? 16 : 8;
            const bool split = (F.G == 256) && !PR, helper = split && rk_ >= 32 - hr_;
            if (helper) {
                LAS float* scr64 = (LAS float*)(F.lds + F.wave * 16640);
                const int hw = ((xcd_ * hr_ + rk_ - (32 - hr_)) * 8 + F.wave), nhw = 64 * hr_;
                if (J == 0) { for (int it = hw; it < MOE_ITEMS64 + HELP_N3A; it += nhw) moe_item64(F.ws, I.p[25], I.p[26], I.p[27], it < MOE_ITEMS64 ? 2 : 3, it < MOE_ITEMS64 ? it : it - MOE_ITEMS64, scr64, F.lane); }
                else { for (int it = HELP_N3A + hw; it < MOE_ITEMS64; it += nhw) moe_item64(F.ws, I.p[25], I.p[26], I.p[27], 3, it, scr64, F.lane); }
                __syncthreads();
            } else
            { pg8::Gemm g{HN, (const bf16*)(F.ws + WS_WQB) + (size_t)J * 1536 * 1024, T, 1536, D}; pg8::StaticOrder S;
              if (split) S.init(T, 1536, 8 * (32 - hr_), rk_ * 8 + xcd_); else S.init(T, 1536, F.G, (int)blockIdx.x);
              EpiHN E{(bf16*)(F.ws + WS_QB), 0, I.p[19] + J * 192, 0, 1, QSCALE, 6, 1536, 9, 1};
              pg8::gemm_phase<EpiHN, pg8::StaticOrder>(F.lds, g, S, E); }
            if (SITE(10) && J == 0) { pg8::Gemm g{(const bf16*)(F.ws + WS_HKV), (const bf16*)(F.ws + WS_WKV), T, 3072, D}; pg8::StaticOrder S; S.init(T, 3072, F.G, (int)blockIdx.x);
              EpiHN E{(bf16*)(F.ws + WS_KS), (WS_VS - WS_KS) / 2, I.p[17], 0, 1, 1.f, 6, 1536, 9, 1};
              pg8::gemm_phase<EpiHN, pg8::StaticOrder>(F.lds, g, S, E); }
        } SEAM(pb + 1);
        if (SITE(11) && IN(pb + 2)) { ENTER();
            att::attnB_phase((LAS char*)F.lds, F.vcu, F.G, (const bf16*)(F.ws + WS_QB), (const bf16*)(F.ws + WS_KS), (const bf16*)(F.ws + WS_VS), (bf16*)(F.ws + WS_OG), (float*)(F.ws + WS_LSE),
                             (const float*)(F.ws + WS_BIASB), (const float*)(F.ws + WS_LAM) + 4 + J * 3);
        } SEAM(pb + 2);
        if (SITE(12) && IN(pb + 3)) { ENTER(); combine_phase(F, (const bf16*)(F.ws + WS_OG), (const float*)(F.ws + WS_LSE), (bf16*)(F.ws + WS_OB)); } SEAM(pb + 3);
        if (SITE(13) && IN(pb + 4)) { ENTER();
            pg8::Gemm g{(const bf16*)(F.ws + WS_OB), (const bf16*)(F.ws + WS_WOB) + (size_t)J * 1024 * 512, T, D, 512}; pg8::StaticOrder S; S.init(T, D, F.G, (int)blockIdx.x);
            EpiResid<false> E{X, Xo, mod + 2048, CTL + CW_XP + (PR ? 4 + L : L) * 1024};
            pg8::gemm_phase<EpiResid<false>, pg8::StaticOrder>(F.lds, g, S, E);
        }
        if (SITE(14) && IN(pb + 5)) { ENTER();
            const int rowblk = F.vcu;
            router_phase(F, X, rowblk, ((ap->ph_hi - ap->ph_lo) > 1 && !PR) ? CTL + CW_XP + L * 1024 : nullptr, CTL + CW_TMO, I.p[6] + L * D, mod + 3072, mod + 4096, HNo, (const float*)(F.ws + WS_RWT) + (size_t)L * 36 * 1024, I.p[22] + L * 4, I.p[24] + L * 32, CTL + CW_GCNT + 2048 * (PR ? 4 + L : L), PR ? (int*)(F.ws + WS_PROBE + 96 * MiB) : ROWTOK, PR ? (float*)(F.ws + WS_PROBE + 100 * MiB) : ROWW, RPMODE);
        } SEAM(pb + 5);
        if (SITE(15) && IN(pb + 6)) { ENTER();
            moe_tables(F, CTL + CW_GCNT + 2048 * L, ROWTOK, ROWW);
            pg8::Gemm g{HN, (const bf16*)(F.ws + WS_MGU) + (size_t)L * 32 * 1024 * 1024, 0, 1024, D};
            MoeOrderG S; S.ul = (const LAS int*)(F.lds + ULIST_OFF); S.tokl = (const LAS int*)(F.lds + TOKL_OFF); S.K2 = 2048; S.cnt = nullptr; S.tmo = nullptr;
            EpiMoeGU E{ACT, CTL + CW_ACT + (PR ? 4 + L : L) * 2560};
            pg8::gemm_phase<EpiMoeGU, MoeOrderG>(F.lds, g, S, E);
        }
        if (SITE(16) && IN(pb + 7)) { ENTER();
            if (!one_launch) moe_tables(F, CTL + CW_GCNT + 2048 * L, ROWTOK, ROWW);
            pg8::Gemm g{ACT, (const bf16*)(F.ws + WS_MDN) + (size_t)L * 32 * 1024 * 512, 0, 1024, 512};
            MoeOrderC S; S.ul = (const LAS int*)(F.lds + ULIST_OFF) + 32; S.tokl = (const LAS int*)(F.lds + TOKL2_OFF); S.K2 = 1024; S.cnt = CTL + CW_ACT + L * 2560; S.tmo = CTL + CW_TMO;
            EpiMoeDown E{YB, (const LAS int*)(F.lds + TOKL2_OFF), (const LAS float*)(F.lds + WL_OFF)};
            pg8::gemm_phase<EpiMoeDown, MoeOrderC>(F.lds, g, S, E);
        } SEAM(pb + 7);
    }
    if (SITE(17) && IN(31)) { ENTER(); final_phase(F, X, YB, MOD + 3 * 4 * 6144 + 5120, PR ? (float*)(F.ws + WS_PROBE) : OUT); }
#undef IN
#undef SEAM
}

extern "C" void kernel_launch(void* const* d_in, const int* in_sizes, int n_in, void* d_out, int out_size, void* d_ws, size_t ws_size, hipStream_t stream) {
    static int grid = 0;
    if (grid == 0) {
        if (n_in != 28 || out_size != T * D || ws_size < WS_END) { fprintf(stderr, "kernel_launch: unexpected problem (n_in %d, out %d, ws %zu); nothing launched\n", n_in, out_size, ws_size); grid = -1; return; }
        int dev = 0, cus = 0, per_cu = 0;
        if (hipGetDevice(&dev) != hipSuccess || hipDeviceGetAttribute(&cus, hipDeviceAttributeMultiprocessorCount, dev) != hipSuccess) { grid = -1; return; }
        if (hipFuncSetAttribute((const void*)fwd_kernel, hipFuncAttributeMaxDynamicSharedMemorySize, LDS_BYTES) != hipSuccess) { fprintf(stderr, "kernel_launch: hipFuncSetAttribute failed\n"); grid = -1; return; }
        if (hipOccupancyMaxActiveBlocksPerMultiprocessor(&per_cu, (const void*)fwd_kernel, 512, LDS_BYTES) != hipSuccess || per_cu < 1) { fprintf(stderr, "kernel_launch: occupancy query says %d\n", per_cu); (void)hipGetLastError(); grid = -1; return; }
        grid = cus < 256 ? cus : 256;
        if (grid != 256) { fprintf(stderr, "kernel_launch: built for a 256-CU device (one workgroup per CU; the worker / helper splits of the GEMM phases assume 8 XCDs x 32 workgroups)\n"); grid = -1; return; }
    }
    if (grid < 0) return;
    (void)hipMemsetAsync((char*)d_ws + WS_CTL, 0, CTL_ZERO_BYTES, stream);
    Args a{};
    for (int i = 0; i < 28; ++i) a.in.p[i] = (const float*)d_in[i];
    a.out = (float*)d_out; a.ws = (unsigned char*)d_ws;
#if MK_N_LAUNCHES == 1
    a.ph_lo = 0; a.ph_hi = N_PHASES;
    hipLaunchKernelGGL(fwd_kernel, dim3(grid), dim3(512), LDS_BYTES, stream, a);
#else
#ifndef PROBE_DUP_MASK
#define PROBE_DUP_MASK 0u
#endif
    for (int p = 0; p < N_PHASES; ++p) { a.ph_lo = p; a.ph_hi = p + 1;
        for (int rep = 0; rep < (((PROBE_DUP_MASK) >> p) & 1u ? 2 : 1); ++rep) { a.probe = rep; hipLaunchKernelGGL(fwd_kernel, dim3(grid), dim3(512), LDS_BYTES, stream, a); } }
#endif
}
```
